# Optimizing an MI355X kernel written in HIP

```python
import math
import jax, jax.numpy as jnp
from jax import lax
import numpy as np

D_MODEL = 1024
BATCH = 8
SEQ = 4096
DEPTH = 2

HG_HEADS = 4
HG_DK = 128
HG_DV = 128
HG_W = HG_HEADS * HG_DK
HG_VW = HG_HEADS * HG_DV
HG_CHUNK = 64
SB_HEADS = 8
SB_DH = 64
SB_W = SB_HEADS * SB_DH
DA_HEADS = 4
DA_DH = 64
DA_DV = 2 * DA_DH
DA_QK = DA_HEADS * 2 * DA_DH
DA_W = DA_HEADS * DA_DV
REL_BUCKETS = 32
REL_MAX_DIST = 128
D_FF = 2816
CONV_W = 3
Q_BLOCK = 128
N_BRANCH = 3
RMS_EPS = 1e-6

IN_SPLITS = (HG_W, HG_W, HG_VW, HG_VW,
             SB_W, SB_W, SB_W,
             DA_QK, DA_QK, DA_W,
             N_BRANCH * D_MODEL)
IN_WIDTH = sum(IN_SPLITS)

kernel_name = 'hybrid_hgrn2_stickbreak_diffattn_block'


def _rmsnorm(x, w):
    xf = x.astype(jnp.float32)
    y = xf * lax.rsqrt(jnp.mean(xf * xf, axis=-1, keepdims=True) + RMS_EPS)
    return (y * w.astype(jnp.float32)).astype(x.dtype)


def _split_cols(z):
    idx = np.cumsum(IN_SPLITS)[:-1].tolist()
    return jnp.split(z, idx, axis=-1)


def _to_heads(a, n_heads):
    b, s, w = a.shape
    return a.reshape(b, s, n_heads, w // n_heads).transpose(0, 2, 1, 3)


def _from_heads(a):
    b, h, s, d = a.shape
    return a.transpose(0, 2, 1, 3).reshape(b, s, h * d)


def _blocks_first(a, axis):
    s = a.shape[axis]
    a = a.reshape(a.shape[:axis] + (s // Q_BLOCK, Q_BLOCK) + a.shape[axis + 1:])
    return jnp.moveaxis(a, axis, 0)


def _blocks_merge(o):
    nb, b, h, qb, d = o.shape
    return jnp.moveaxis(o, 0, 2).reshape(b, h, nb * qb, d)


def _t5_bucket(dist):
    n = jnp.maximum(dist, 0)
    max_exact = REL_BUCKETS // 2
    scaled = jnp.log(jnp.maximum(n, 1).astype(jnp.float32) / max_exact) / math.log(REL_MAX_DIST / max_exact)
    large = jnp.minimum(max_exact + (scaled * (REL_BUCKETS - max_exact)).astype(jnp.int32), REL_BUCKETS - 1)
    return jnp.where(n < max_exact, n, large)


def _lambda_init(layer_idx):
    return 0.8 - 0.6 * math.exp(-0.3 * layer_idx)


def hgrn2_mixer(q, f_logit, i, g, lb, onorm_w):
    b, s, _ = q.shape
    lbf = lb.astype(jnp.float32)
    zf = f_logit.astype(jnp.float32)
    log_f = jnp.logaddexp(jnp.log(lbf), jnp.log1p(-lbf) + jax.nn.log_sigmoid(zf))
    key = (1.0 - lbf) * jax.nn.sigmoid(-zf)
    qh = _to_heads(q.astype(jnp.float32) * HG_DK ** -0.5, HG_HEADS)
    kh = _to_heads(key, HG_HEADS)
    gh = _to_heads(log_f, HG_HEADS)
    vh = _to_heads(i.astype(jnp.float32), HG_HEADS)
    n = s // HG_CHUNK

    def chunks(a):
        return jnp.moveaxis(a.reshape(b, HG_HEADS, n, HG_CHUNK, a.shape[-1]), 2, 0)

    causal = jnp.tril(jnp.ones((HG_CHUNK, HG_CHUNK), dtype=bool))[:, :, None]

    def step(state, inp):
        qc, kc, vc, gc = inp
        cum = jnp.cumsum(gc, axis=2)
        o_inter = jnp.einsum('bhtk,bhkv->bhtv', qc * jnp.exp(cum), state)
        rel = jnp.where(causal, cum[:, :, :, None, :] - cum[:, :, None, :, :], -jnp.inf)
        scores = jnp.einsum('bhtk,bhtsk,bhsk->bhts', qc, jnp.exp(rel), kc)
        o = o_inter + jnp.einsum('bhts,bhsv->bhtv', scores, vc)
        last = cum[:, :, -1:, :]
        state = (jnp.exp(last[:, :, 0, :, None]) * state
                 + jnp.einsum('bhsk,bhsv->bhkv', kc * jnp.exp(last - cum), vc))
        return state, o

    state0 = jnp.zeros((b, HG_HEADS, HG_DK, HG_DV), jnp.float32)
    _, o = lax.scan(step, state0, (chunks(qh), chunks(kh), chunks(vh), chunks(gh)))
    o = jnp.moveaxis(o, 0, 2).reshape(b, HG_HEADS, s, HG_DV)
    o = _rmsnorm(o, onorm_w)
    return _from_heads(o) * jax.nn.silu(g.astype(jnp.float32))


def stick_breaking_mixer(q, k, v):
    s = q.shape[1]
    qh, kh, vh = _to_heads(q, SB_HEADS), _to_heads(k, SB_HEADS), _to_heads(v, SB_HEADS)
    pos = jnp.arange(s)

    def block(args):
        qb, t0 = args
        z = jnp.einsum('bhqd,bhkd->bhqk', qb, kh).astype(jnp.float32) * SB_DH ** -0.5
        t = t0 + jnp.arange(Q_BLOCK)
        mask = pos[None, :] < t[:, None]
        log_1mb = jnp.where(mask, jax.nn.log_sigmoid(-z), 0.0)
        later = lax.cumsum(log_1mb, axis=3, reverse=True) - log_1mb
        w = jnp.where(mask, jnp.exp(jax.nn.log_sigmoid(z) + later), 0.0)
        return jnp.einsum('bhqk,bhkd->bhqd', w.astype(vh.dtype), vh)

    starts = jnp.arange(s // Q_BLOCK, dtype=jnp.int32) * Q_BLOCK
    o = lax.map(block, (_blocks_first(qh, 2), starts))
    return _from_heads(_blocks_merge(o))


def diff_attention_mixer(q, k, v, lam, onorm_w, rel_bias, lam_init):
    b, s, _ = q.shape
    qh = q.reshape(b, s, DA_HEADS, 2, DA_DH).transpose(0, 2, 3, 1, 4)
    kh = k.reshape(b, s, DA_HEADS, 2, DA_DH).transpose(0, 2, 3, 1, 4)
    vh = _to_heads(v, DA_HEADS)
    lamf = lam.astype(jnp.float32)
    lam_full = jnp.exp(jnp.sum(lamf[0] * lamf[1])) - jnp.exp(jnp.sum(lamf[2] * lamf[3])) + lam_init
    table = rel_bias.astype(jnp.float32)
    pos = jnp.arange(s)

    def block(args):
        qb, t0 = args
        t = t0 + jnp.arange(Q_BLOCK)
        dist = t[:, None] - pos[None, :]
        bias = jnp.transpose(table[_t5_bucket(dist)], (2, 0, 1))[None, :, None]
        logits = jnp.einsum('bhmqd,bhmkd->bhmqk', qb, kh).astype(jnp.float32) * DA_DH ** -0.5 + bias
        logits = jnp.where(dist >= 0, logits, -jnp.inf)
        p = jax.nn.softmax(logits, axis=-1)
        w = p[:, :, 0] - lam_full * p[:, :, 1]
        return jnp.einsum('bhqk,bhkd->bhqd', w.astype(vh.dtype), vh)

    starts = jnp.arange(s // Q_BLOCK, dtype=jnp.int32) * Q_BLOCK
    o = _blocks_merge(lax.map(block, (_blocks_first(qh, 3), starts)))
    o = _rmsnorm(o, onorm_w) * (1.0 - lam_init)
    return _from_heads(o)


def conv_glu_ffn(h, w_up, conv_w, conv_b, w_down):
    u = h @ w_up
    s = u.shape[1]
    up = jnp.pad(u, ((0, 0), (CONV_W - 1, 0), (0, 0)))
    u = conv_b + sum(up[:, j:j + s] * conv_w[j] for j in range(CONV_W))
    gate, val = jnp.split(u, 2, axis=-1)
    return (jax.nn.silu(gate) * val) @ w_down


def setup_inputs(seed: int = 0) -> dict:
    key = jax.random.key(seed)
    ks = jax.random.split(key, 18)

    def nrm(k, shape, scale):
        return jax.random.normal(k, shape, jnp.float32) * scale

    ff2 = 2 * D_FF
    return {
        'x': nrm(ks[0], (BATCH, SEQ, D_MODEL), 1.0),
        'attn_norm_w': 1.0 + nrm(ks[1], (DEPTH, D_MODEL), 0.05),
        'w_in': nrm(ks[2], (DEPTH, D_MODEL, IN_WIDTH), D_MODEL ** -0.5),
        'hgrn_lower_bounds': nrm(ks[3], (DEPTH, HG_W), 0.5),
        'hgrn_onorm_w': 1.0 + nrm(ks[4], (DEPTH, HG_DV), 0.05),
        'w_hgrn_out': nrm(ks[5], (DEPTH, HG_VW, D_MODEL), HG_VW ** -0.5),
        'w_sb_out': nrm(ks[6], (DEPTH, SB_W, D_MODEL), SB_W ** -0.5),
        'diff_lambda': nrm(ks[7], (DEPTH, 4, DA_DH), 0.1),
        'diff_onorm_w': 1.0 + nrm(ks[8], (DEPTH, DA_DV), 0.05),
        'w_diff_out': nrm(ks[9], (DEPTH, DA_W, D_MODEL), DA_W ** -0.5),
        'rel_bias': nrm(ks[10], (REL_BUCKETS, DA_HEADS), 0.5),
        'w_out': nrm(ks[11], (DEPTH, D_MODEL, D_MODEL), D_MODEL ** -0.5),
        'ffn_norm_w': 1.0 + nrm(ks[12], (DEPTH, D_MODEL), 0.05),
        'w_up': nrm(ks[13], (DEPTH, D_MODEL, ff2), D_MODEL ** -0.5),
        'conv_w': nrm(ks[14], (DEPTH, CONV_W, ff2), CONV_W ** -0.5),
        'conv_b': nrm(ks[15], (DEPTH, ff2), 0.01),
        'w_down': nrm(ks[16], (DEPTH, D_FF, D_MODEL), D_FF ** -0.5),
        'final_norm_w': 1.0 + nrm(ks[17], (D_MODEL,), 0.05),
    }


def reference(x, attn_norm_w, w_in, hgrn_lower_bounds, hgrn_onorm_w, w_hgrn_out, w_sb_out,
              diff_lambda, diff_onorm_w, w_diff_out, rel_bias, w_out, ffn_norm_w, w_up,
              conv_w, conv_b, w_down, final_norm_w):
    lb_all = jnp.cumsum(jax.nn.softmax(hgrn_lower_bounds.astype(jnp.float32), axis=0), axis=0)
    lb_all = lb_all - lb_all[0]
    for l in range(DEPTH):
        h = _rmsnorm(x, attn_norm_w[l])
        (hq, hf, hi, hg, sq, sk, sv, dq, dk, dv, gate_logits) = _split_cols(h @ w_in[l])
        y_a = hgrn2_mixer(hq, hf, hi, hg, lb_all[l], hgrn_onorm_w[l]).astype(x.dtype) @ w_hgrn_out[l]
        y_b = stick_breaking_mixer(sq, sk, sv).astype(x.dtype) @ w_sb_out[l]
        y_c = diff_attention_mixer(dq, dk, dv, diff_lambda[l], diff_onorm_w[l], rel_bias,
                                   _lambda_init(l)).astype(x.dtype) @ w_diff_out[l]
        g_a, g_b, g_c = jnp.split(jax.nn.sigmoid(gate_logits), N_BRANCH, axis=-1)
        x = x + ((g_a * y_a + g_b * y_b + g_c * y_c) @ w_out[l]).astype(x.dtype)
        x = x + conv_glu_ffn(_rmsnorm(x, ffn_norm_w[l]), w_up[l], conv_w[l], conv_b[l],
                             w_down[l]).astype(x.dtype)
    return _rmsnorm(x, final_norm_w)
```

```cpp
#include <hip/hip_runtime.h>
#include <hip/hip_cooperative_groups.h>
#include <cstdio>
#include <cstdint>
namespace cg = cooperative_groups;

#ifndef REP_SB
#define REP_SB 1
#endif
#ifndef REP_DF
#define REP_DF 1
#endif
#ifndef MK_SINGLE
#define MK_SINGLE 1
#endif

__device__ __forceinline__ int opq_tid() { int t = threadIdx.x; asm volatile("" : "+v"(t)); return t; }
__device__ __forceinline__ int opq_bid() { int b = blockIdx.x; asm volatile("" : "+s"(b)); return b; }

typedef unsigned long long ssq_t;
__device__ __forceinline__ float ssq_f(ssq_t v) { return __ull2float_rn(v) * 5.9604644775390625e-08f; }
__device__ __forceinline__ ssq_t ssq_q(float s) { return (ssq_t)__float2ull_rn(s * 16777216.0f); }

namespace pg8 {
#define PG8_LAS __attribute__((address_space(3)))
typedef unsigned short bf16_t;
typedef short bf16x8 __attribute__((ext_vector_type(8)));
typedef float f32x4 __attribute__((ext_vector_type(4)));
typedef unsigned u32x4 __attribute__((ext_vector_type(4)));
constexpr int BM = 256, BK = 64, HALF = 128, HTB = HALF * BK * 2  , STAGE_BYTES = 8 * HTB, NXCD = 8, WGM = 8;

__host__ __device__ __forceinline__ int lds_byte(int r, int c) { const int st = (r >> 4) * 2 + (c >> 5), rr = r & 15, cc = c & 31, ob = rr * 64 + cc * 2; return st * 1024 + (ob ^ (((ob >> 9) & 1) << 5)); }
__host__ __device__ __forceinline__ void stage_rc(int b, int& R, int& C) { const int st = b / 1024, sb = b % 1024, swz = sb ^ (((sb >> 9) & 1) << 5); R = (st >> 1) * 16 + swz / 64; C = (st & 1) * 32 + (swz % 64) / 2; }
__host__ __device__ __forceinline__ int perm32(int rho) { const int n = rho >> 4, i = rho & 15; return 8 * (i >> 2) + 4 * n + (i & 3); }

struct Unit { int pm, pn; };
struct Gemm { const bf16_t* A; const bf16_t* Bt; int M, N, K; int a_grp = 0; size_t a_stride = 0; };

struct StaticOrder {
    int nM, nN, nwg, G, c;
    __host__ __device__ void init(int M, int N, int G_, int c_) { nM = M / BM; nN = N / BM; nwg = nM * nN; G = G_; c = c_; }
    __host__ __device__ bool next(int i, Unit& u) const {
        const long L = (long)i * G + c; if (L >= nwg) return false;
        int wgid = (int)L; { const int q = nwg / NXCD, r = nwg % NXCD, xcd = wgid % NXCD, off = wgid / NXCD; wgid = (xcd < r ? xcd * (q + 1) : r * (q + 1) + (xcd - r) * q) + off; }
        const int nig = WGM * nN, gid = wgid / nig, fm = gid * WGM, gsz = (nM - fm) < WGM ? (nM - fm) : WGM;
        u.pm = fm + ((wgid % nig) % gsz); u.pn = (wgid % nig) / gsz; return true;
    }
    __device__ __forceinline__ void a_ready(const Unit&) const {}
    __device__ __forceinline__ void done(const Unit&) const {}
};
struct BranchOrder {
    int G, c;
    __host__ __device__ void init(int G_, int c_) { G = G_; c = c_; }
    __host__ __device__ bool next(int i, Unit& u) const { const int T = c + G * (i / 3), br = i % 3; if (T >= 256) return false; u.pm = T >> 2; u.pn = br * 4 + (T & 3); return true; }
    __device__ __forceinline__ void a_ready(const Unit&) const {}
    __device__ __forceinline__ void done(const Unit&) const {}
};
__device__ __forceinline__ unsigned cvt_pk_bf16(float lo, float hi) { unsigned r; asm("v_cvt_pk_bf16_f32 %0, %1, %2" : "=v"(r) : "v"(lo), "v"(hi)); return r; }
typedef unsigned u32x2 __attribute__((ext_vector_type(2)));
__device__ __forceinline__ float bflo(unsigned w) { return __uint_as_float(w << 16); }
__device__ __forceinline__ float bfhi(unsigned w) { return __uint_as_float(w & 0xffff0000u); }
__device__ __forceinline__ float sigmoidf_(float x) { return __builtin_amdgcn_rcpf(1.0f + __expf(-x)); }

struct EpiRowScaleBf16 {
    static constexpr bool PERM = true, AFTER_DRAIN = false, CHAIN = false;
    bf16_t* O0; int ld0; int split_pn; bf16_t* O1; int ld1; const ssq_t* ssq;
    __device__ __forceinline__ void operator()(const f32x4 (&acc)[2][2][4][2], const Unit& u, int wr, int wc, int fr, int fq) const {
        const int row0 = u.pm * BM + wr * 64 + fr;
        const bool sec = u.pn >= split_pn;
        bf16_t* base = sec ? O1 : O0; const int ld = sec ? ld1 : ld0;
        const int col0 = (sec ? (u.pn - split_pn) : u.pn) * BM + wc * 32 + 8 * fq;
        ssq_t sq[2][4];
#pragma unroll
        for (int ai = 0; ai < 2; ++ai)
#pragma unroll
            for (int m = 0; m < 4; ++m) sq[ai][m] = ssq[row0 + ai * HALF + m * 16];
#pragma unroll
        for (int ai = 0; ai < 2; ++ai)
#pragma unroll
            for (int m = 0; m < 4; ++m) {
                const int row = row0 + ai * HALF + m * 16;
                const float rs = rsqrtf(ssq_f(sq[ai][m]) * (1.0f / 1024.0f) + 1e-6f);
                bf16_t* rowp = base + (size_t)row * ld + col0;
#pragma unroll
                for (int bj = 0; bj < 2; ++bj) {
                    f32x4 v0 = acc[ai][bj][m][0] * rs, v1 = acc[ai][bj][m][1] * rs;
                    if (sec) {
                        unsigned q0 = 0u, q1 = 0u;
#pragma unroll
                        for (int e = 0; e < 4; ++e) {
                            q0 = __builtin_amdgcn_cvt_pk_u8_f32(__builtin_rintf(fmaxf(sigmoidf_(v0[e]) * 255.0f, 1.0f)), e, q0);
                            q1 = __builtin_amdgcn_cvt_pk_u8_f32(__builtin_rintf(fmaxf(sigmoidf_(v1[e]) * 255.0f, 1.0f)), e, q1);
                        }
                        u32x2 w8; w8.x = q0; w8.y = q1;
                        *(u32x2*)((unsigned char*)O1 + (size_t)row * ld1 + col0 + bj * HALF) = w8;
                    } else {
                    u32x4 w; w.x = cvt_pk_bf16(v0[0], v0[1]); w.y = cvt_pk_bf16(v0[2], v0[3]); w.z = cvt_pk_bf16(v1[0], v1[1]); w.w = cvt_pk_bf16(v1[2], v1[3]);
                    *(u32x4*)(rowp + bj * HALF) = w;
                    }
                }
            }
    }
};
struct EpiColScaleBf16 {
    static constexpr bool PERM = true, AFTER_DRAIN = false, CHAIN = false;
    bf16_t* O; int ld; const ssq_t* ssq;
    __device__ __forceinline__ void operator()(const f32x4 (&acc)[2][2][4][2], const Unit& u, int wr, int wc, int fr, int fq) const {
        const int row0 = u.pm * BM + wr * 64 + fr, col0 = u.pn * BM + wc * 32 + 8 * fq;
        f32x4 rs[2][2];
#pragma unroll
        for (int bj = 0; bj < 2; ++bj)
#pragma unroll
            for (int n = 0; n < 2; ++n) { ssq_t q[4];
#pragma unroll
                for (int e = 0; e < 4; ++e) q[e] = ssq[col0 + bj * HALF + 4 * n + e];
#pragma unroll
                for (int e = 0; e < 4; ++e) rs[bj][n][e] = rsqrtf(ssq_f(q[e]) * (1.0f / 1024.0f) + 1e-6f); }
#pragma unroll
        for (int ai = 0; ai < 2; ++ai)
#pragma unroll
            for (int m = 0; m < 4; ++m) {
                bf16_t* rowp = O + (size_t)(row0 + ai * HALF + m * 16) * ld + col0;
#pragma unroll
                for (int bj = 0; bj < 2; ++bj) {
                    const f32x4 v0 = acc[ai][bj][m][0] * rs[bj][0], v1 = acc[ai][bj][m][1] * rs[bj][1];
                    u32x4 w; w.x = cvt_pk_bf16(v0[0], v0[1]); w.y = cvt_pk_bf16(v0[2], v0[3]); w.z = cvt_pk_bf16(v1[0], v1[1]); w.w = cvt_pk_bf16(v1[2], v1[3]);
                    *(u32x4*)(rowp + bj * HALF) = w;
                }
            }
    }
};
__device__ __forceinline__ float dpp_ror1(float x) { return __builtin_bit_cast(float, __builtin_amdgcn_update_dpp(0, __builtin_bit_cast(int, x), 0x121, 0xf, 0xf, false)); }
__device__ __forceinline__ float dpp_ror2(float x) { return __builtin_bit_cast(float, __builtin_amdgcn_update_dpp(0, __builtin_bit_cast(int, x), 0x122, 0xf, 0xf, false)); }
struct EpiConvGate {
    static constexpr bool PERM = true, AFTER_DRAIN = false, CHAIN = false;
    bf16_t* act; bf16_t* halo; const ssq_t* ssq; const float* cw; const float* cb;
    __device__ __forceinline__ void operator()(const f32x4 (&acc)[2][2][4][2], const Unit& u, int wr, int wc, int fr_, int fq_) const {
        int lane_ = fr_ + 16 * fq_; asm volatile("" : "+v"(lane_));
#pragma unroll
        for (int n = 0; n < 2; ++n) {
#pragma unroll
            for (int ai = 0; ai < 2; ++ai) {
                asm volatile("" : "+v"(lane_));
                const int fr = lane_ & 15, fq = lane_ >> 4;
                const int row0 = u.pm * BM + wr * 64 + fr, chl = wc * 32 + 8 * fq, c0 = u.pn * 128 + chl;
                const int c = c0 + 4 * n;
                f32x4 g[4], v[4];
                ssq_t sq[4];
#pragma unroll
                for (int m = 0; m < 4; ++m) sq[m] = ssq[row0 + ai * HALF + m * 16];
#pragma unroll
                for (int m = 0; m < 4; ++m) { const float rs = rsqrtf(ssq_f(sq[m]) * (1.0f / 1024.0f) + 1e-6f); g[m] = acc[ai][0][m][n] * rs; v[m] = acc[ai][1][m][n] * rs; }
                const int grp = u.pm * 4 + ai * 2 + wr;
                bf16_t* hb = halo + (size_t)grp * 4 * 5632 + u.pn * 256 + chl + 4 * n;
                if (fr < 2) {
                    u32x2 a, b; a.x = cvt_pk_bf16(g[0][0], g[0][1]); a.y = cvt_pk_bf16(g[0][2], g[0][3]); b.x = cvt_pk_bf16(v[0][0], v[0][1]); b.y = cvt_pk_bf16(v[0][2], v[0][3]);
                    *(u32x2*)(hb + (size_t)fr * 5632) = a; *(u32x2*)(hb + (size_t)fr * 5632 + 128) = b;
                }
                if (fr >= 14) {
                    u32x2 a, b; a.x = cvt_pk_bf16(g[3][0], g[3][1]); a.y = cvt_pk_bf16(g[3][2], g[3][3]); b.x = cvt_pk_bf16(v[3][0], v[3][1]); b.y = cvt_pk_bf16(v[3][2], v[3][3]);
                    *(u32x2*)(hb + (size_t)(fr - 12) * 5632) = a; *(u32x2*)(hb + (size_t)(fr - 12) * 5632 + 128) = b;
                }
                __builtin_amdgcn_sched_barrier(0);
                {
                    const f32x4 w0 = *(const f32x4*)(cw + c), w1 = *(const f32x4*)(cw + 5632 + c), w2 = *(const f32x4*)(cw + 2 * 5632 + c), bb = *(const f32x4*)(cb + c);
                    f32x4 p1 = {0.f, 0.f, 0.f, 0.f}, p2 = p1;
#pragma unroll
                    for (int m = 0; m < 4; ++m) {
                        f32x4 r1, r2;
#pragma unroll
                        for (int e = 0; e < 4; ++e) { r1[e] = dpp_ror1(g[m][e]); r2[e] = dpp_ror2(g[m][e]); }
                        f32x4 x1, x2;
#pragma unroll
                        for (int e = 0; e < 4; ++e) { x1[e] = (fr >= 1) ? r1[e] : p1[e]; x2[e] = (fr >= 2) ? r2[e] : p2[e]; }
                        const f32x4 gg = bb + w0 * x2 + w1 * x1 + w2 * g[m];
#pragma unroll
                        for (int e = 0; e < 4; ++e) g[m][e] = gg[e] * sigmoidf_(gg[e]);
                        p1 = r1; p2 = r2;
                    }
                }
                __builtin_amdgcn_sched_barrier(0);
                {
                    const f32x4 w0 = *(const f32x4*)(cw + 2816 + c), w1 = *(const f32x4*)(cw + 5632 + 2816 + c), w2 = *(const f32x4*)(cw + 2 * 5632 + 2816 + c), bb = *(const f32x4*)(cb + 2816 + c);
                    f32x4 p1 = {0.f, 0.f, 0.f, 0.f}, p2 = p1;
#pragma unroll
                    for (int m = 0; m < 4; ++m) {
                        f32x4 r1, r2, og;
#pragma unroll
                        for (int e = 0; e < 4; ++e) { r1[e] = dpp_ror1(v[m][e]); r2[e] = dpp_ror2(v[m][e]); }
                        f32x4 x1, x2;
#pragma unroll
                        for (int e = 0; e < 4; ++e) { x1[e] = (fr >= 1) ? r1[e] : p1[e]; x2[e] = (fr >= 2) ? r2[e] : p2[e]; }
                        og = g[m] * (bb + w0 * x2 + w1 * x1 + w2 * v[m]);
                        p1 = r1; p2 = r2;
                        if (m > 0 || fr >= 2) { u32x2 w; w.x = cvt_pk_bf16(og[0], og[1]); w.y = cvt_pk_bf16(og[2], og[3]); *(u32x2*)(act + (size_t)(row0 + ai * HALF + m * 16) * 2816 + c) = w; }
                    }
                }
                __builtin_amdgcn_sched_barrier(0);
            }
        }
    }
};
struct EpiGateAcc {
    static constexpr bool PERM = true, AFTER_DRAIN = false, CHAIN = true;
    const unsigned char* gates; bf16_t* mb;
    __device__ __forceinline__ bool keep(const Unit& u) const { return (u.pn >> 2) < 2; }
    __device__ __forceinline__ void operator()(f32x4 (&acc)[2][2][4][2], const Unit& u, int wr, int wc, int fr, int fq) const {
        const int br = u.pn >> 2, gcol0 = br * 1024;
        const int row0 = u.pm * BM + wr * 64 + fr, col0 = (u.pn & 3) * BM + wc * 32 + 8 * fq;
#pragma unroll
        for (int ai = 0; ai < 2; ++ai) {
            u32x2 g[4][2], gn[4][2];
#pragma unroll
            for (int mm = 0; mm < 4; ++mm)
#pragma unroll
                for (int bj = 0; bj < 2; ++bj) {
                    const size_t off = (size_t)(row0 + ai * HALF + mm * 16) * 3072 + gcol0 + col0 + bj * HALF;
                    g[mm][bj] = *(const u32x2*)(gates + off);
                    if (br < 2) gn[mm][bj] = *(const u32x2*)(gates + off + 1024);
                }
#pragma unroll
            for (int mm = 0; mm < 4; ++mm)
#pragma unroll
                for (int bj = 0; bj < 2; ++bj) {
                    const int row = row0 + ai * HALF + mm * 16, col = col0 + bj * HALF;
                    const u32x2 gg = g[mm][bj];
                    f32x4 v0 = acc[ai][bj][mm][0], v1 = acc[ai][bj][mm][1];
#pragma unroll
                    for (int e = 0; e < 4; ++e) { v0[e] *= (float)((gg.x >> (8 * e)) & 0xffu); v1[e] *= (float)((gg.y >> (8 * e)) & 0xffu); }
                    if (br < 2) {
                        const u32x2 nn = gn[mm][bj];
#pragma unroll
                        for (int e = 0; e < 4; ++e) { v0[e] *= __builtin_amdgcn_rcpf((float)((nn.x >> (8 * e)) & 0xffu)); v1[e] *= __builtin_amdgcn_rcpf((float)((nn.y >> (8 * e)) & 0xffu)); }
                        acc[ai][bj][mm][0] = v0; acc[ai][bj][mm][1] = v1;
                    } else {
                        v0 = v0 * (1.0f / 255.0f); v1 = v1 * (1.0f / 255.0f);
                        u32x4 w; w.x = cvt_pk_bf16(v0[0], v0[1]); w.y = cvt_pk_bf16(v0[2], v0[3]); w.z = cvt_pk_bf16(v1[0], v1[1]); w.w = cvt_pk_bf16(v1[2], v1[3]);
                        *(u32x4*)(mb + (size_t)row * 1024 + col) = w;
                    }
                }
        }
    }
};
struct EpiResid {
    static constexpr bool PERM = true, AFTER_DRAIN = false, CHAIN = false;
    float* dst; bf16_t* xb; ssq_t* ssq;
    __device__ __forceinline__ void operator()(const f32x4 (&acc)[2][2][4][2], const Unit& u, int wr, int wc, int fr, int fq) const {
        const int row0 = u.pm * BM + wr * 64 + fr, col0 = u.pn * BM + wc * 32 + 8 * fq;
#pragma unroll
        for (int ai = 0; ai < 2; ++ai) {
            u32x4 px[4][2];
#pragma unroll
            for (int mm = 0; mm < 4; ++mm)
#pragma unroll
                for (int bj = 0; bj < 2; ++bj) px[mm][bj] = *(const u32x4*)(xb + (size_t)(row0 + ai * HALF + mm * 16) * 1024 + col0 + bj * HALF);
#pragma unroll
            for (int mm = 0; mm < 4; ++mm) {
                const int row = row0 + ai * HALF + mm * 16;
                float s = 0.f;
#pragma unroll
                for (int bj = 0; bj < 2; ++bj) {
                    const size_t off = (size_t)row * 1024 + col0 + bj * HALF;
                    const u32x4 p = px[mm][bj];
                    f32x4 v0 = acc[ai][bj][mm][0], v1 = acc[ai][bj][mm][1];
                    v0[0] += bflo(p.x); v0[1] += bfhi(p.x); v0[2] += bflo(p.y); v0[3] += bfhi(p.y); v1[0] += bflo(p.z); v1[1] += bfhi(p.z); v1[2] += bflo(p.w); v1[3] += bfhi(p.w);
                    if (dst) { *(f32x4*)(dst + off) = v0; *(f32x4*)(dst + off + 4) = v1; }
                    u32x4 w; w.x = cvt_pk_bf16(v0[0], v0[1]); w.y = cvt_pk_bf16(v0[2], v0[3]); w.z = cvt_pk_bf16(v1[0], v1[1]); w.w = cvt_pk_bf16(v1[2], v1[3]);
                    *(u32x4*)(xb + off) = w;
                    s += (v0[0] * v0[0] + v0[1] * v0[1]) + (v0[2] * v0[2] + v0[3] * v0[3]) + (v1[0] * v1[0] + v1[1] * v1[1]) + (v1[2] * v1[2] + v1[3] * v1[3]);
                }
                s += __shfl_xor(s, 16); s += __shfl_xor(s, 32);
                if (fq == 0) atomicAdd(ssq + row, ssq_q(s));
            }
        }
    }
};
template <class Epi, class Sched, bool ALIGN_EPI = false, bool SP2 = false>
__device__ __forceinline__ void gemm_phase(PG8_LAS unsigned char* lds, const Gemm g, const Sched& S, const Epi& E) {
    const int tid = opq_tid(), wid = __builtin_amdgcn_readfirstlane(tid >> 6), lane = tid & 63, wr = wid >> 2, wc = wid & 3, fr = lane & 15, fq = lane >> 4;
    const int K = g.K, nt = K / BK;
    unsigned voffA[2], voffB[2];
#pragma unroll
    for (int i = 0; i < 2; ++i) { int R, C; stage_rc(tid * 16 + i * 8192, R, C); const int Rb = Epi::PERM ? ((R & ~31) + perm32(R & 31)) : R;
        voffA[i] = (unsigned)(R * K + C) * 2u; voffB[i] = (unsigned)(Rb * K + C) * 2u; }
    const size_t kstep = (size_t)(BK * 2);
    const size_t hstep = (size_t)HALF * K * 2;
    const size_t tstep = 2 * hstep;
    const unsigned ldsw = (unsigned)wid * 1024u;
    const int aoff = lds_byte(wr * 64 + fr, fq * 8), boff = lds_byte(wc * 32 + fr, fq * 8);
#define PG8_SA(b, h) (((b) * 2 + (h)) * HTB)
#define PG8_SB(b, h) ((4 + (b) * 2 + (h)) * HTB)
#define PG8_STAGE(bufoff, gbase, voff) do { _Pragma("unroll") for (int _i = 0; _i < 2; ++_i) \
        __builtin_amdgcn_global_load_lds((const unsigned*)((const char*)(gbase) + (voff)[_i]), (PG8_LAS unsigned*)(lds + (bufoff) + ldsw + _i * 8192), 16, 0, 0); } while (0)
#define PG8_LDA(dst, b, h) do { _Pragma("unroll") for (int m = 0; m < 4; ++m) _Pragma("unroll") for (int k = 0; k < 2; ++k) dst[m][k] = *(const PG8_LAS bf16x8*)(lds + PG8_SA(b, h) + aoff + m * 2048 + k * 1024); } while (0)
#define PG8_LDB(dst, b, h) do { _Pragma("unroll") for (int n = 0; n < 2; ++n) _Pragma("unroll") for (int k = 0; k < 2; ++k) dst[n][k] = *(const PG8_LAS bf16x8*)(lds + PG8_SB(b, h) + boff + n * 2048 + k * 1024); } while (0)
#define PG8_MMA(ai, bj, At, Bt) do { __builtin_amdgcn_s_setprio(1); _Pragma("unroll") for (int m = 0; m < 4; ++m) _Pragma("unroll") for (int n = 0; n < 2; ++n) _Pragma("unroll") for (int k = 0; k < 2; ++k) \
        acc[ai][bj][m][n] = __builtin_amdgcn_mfma_f32_16x16x32_bf16(Bt[n][k], At[m][k], acc[ai][bj][m][n], 0, 0, 0); __builtin_amdgcn_s_setprio(0); } while (0)
#define PG8_WAIT_V(n) asm volatile("s_waitcnt vmcnt(" #n ")" ::: "memory")
#define PG8_WAIT_L(n) asm volatile("s_waitcnt lgkmcnt(" #n ")" ::: "memory")
#define PG8_BAR __builtin_amdgcn_s_barrier()
#define PG8_SCHED __builtin_amdgcn_sched_barrier(0)
    Unit cur, nxt; int ui = 0;
    if (!S.next(0, cur)) return;
    f32x4 acc[2][2][4][2];
#pragma unroll
    for (int a = 0; a < 2; ++a)
#pragma unroll
        for (int b = 0; b < 2; ++b)
#pragma unroll
            for (int m = 0; m < 4; ++m)
#pragma unroll
                for (int n = 0; n < 2; ++n) acc[a][b][m][n] = (f32x4){0.f, 0.f, 0.f, 0.f};
    bf16x8 At[4][2], B0[2][2], B1[2][2];
    const char* cA = (const char*)g.A + (size_t)cur.pm * tstep + (g.a_grp ? (size_t)(cur.pn / g.a_grp) * g.a_stride * 2 : 0); const char* cB = (const char*)g.Bt + (size_t)cur.pn * tstep;
    S.a_ready(cur);
    if constexpr (SP2) {
        PG8_STAGE(PG8_SB(0, 0), cB, voffB); PG8_STAGE(PG8_SB(0, 1), cB + hstep, voffB); PG8_STAGE(PG8_SA(0, 0), cA, voffA); PG8_STAGE(PG8_SA(0, 1), cA + hstep, voffA);
        if (wr == 1) PG8_BAR;
        PG8_WAIT_V(2); PG8_BAR;
        PG8_STAGE(PG8_SB(1, 0), cB + kstep, voffB); PG8_STAGE(PG8_SA(1, 0), cA + kstep, voffA); PG8_STAGE(PG8_SB(1, 1), cB + hstep + kstep, voffB);
        PG8_WAIT_V(6); PG8_BAR;
    } else {
        PG8_STAGE(PG8_SB(0, 0), cB, voffB); PG8_STAGE(PG8_SA(0, 0), cA, voffA); PG8_STAGE(PG8_SB(0, 1), cB + hstep, voffB); PG8_STAGE(PG8_SA(0, 1), cA + hstep, voffA);
        if (wr == 1) PG8_BAR;
        PG8_WAIT_V(4); PG8_BAR;
        PG8_STAGE(PG8_SB(1, 0), cB + kstep, voffB); PG8_STAGE(PG8_SA(1, 0), cA + kstep, voffA); PG8_STAGE(PG8_SB(1, 1), cB + hstep + kstep, voffB);
        PG8_WAIT_V(6); PG8_BAR;
    }
    for (;;) {
        const bool has_next = S.next(ui + 1, nxt);
        const char* nA = has_next ? (const char*)g.A + (size_t)nxt.pm * tstep + (g.a_grp ? (size_t)(nxt.pn / g.a_grp) * g.a_stride * 2 : 0) : cA; const char* nB = has_next ? (const char*)g.Bt + (size_t)nxt.pn * tstep : cB;
        for (int t = 0; t < nt; t += 2) {
            const bool last = (t == nt - 2);
            const char* a1 = cA + (size_t)(t + 1) * kstep;
            const char* a2 = last ? nA : cA + (size_t)(t + 2) * kstep; const char* b2 = last ? nB : cB + (size_t)(t + 2) * kstep;
            const char* a3 = a2 + kstep; const char* b3 = b2 + kstep;
            if (last && has_next) S.a_ready(nxt);
            if constexpr (SP2) {
            PG8_LDB(B0, 0, 0); PG8_LDB(B1, 0, 1); PG8_SCHED; PG8_LDA(At, 0, 0); PG8_STAGE(PG8_SA(1, 1), a1 + hstep, voffA);
            PG8_WAIT_V(8); PG8_WAIT_L(0); PG8_BAR; PG8_MMA(0, 0, At, B0); PG8_MMA(0, 1, At, B1); PG8_BAR; PG8_SCHED;
            PG8_LDA(At, 0, 1); PG8_STAGE(PG8_SB(0, 0), b2, voffB); PG8_STAGE(PG8_SB(0, 1), b2 + hstep, voffB); PG8_STAGE(PG8_SA(0, 0), a2, voffA);
            PG8_WAIT_V(8); PG8_WAIT_L(0); PG8_BAR; PG8_MMA(1, 0, At, B0); PG8_MMA(1, 1, At, B1); PG8_BAR; PG8_SCHED;
            PG8_LDB(B0, 1, 0); PG8_LDB(B1, 1, 1); PG8_SCHED; PG8_LDA(At, 1, 0); PG8_STAGE(PG8_SA(0, 1), a2 + hstep, voffA);
            PG8_WAIT_V(8); PG8_WAIT_L(0); PG8_BAR; PG8_MMA(0, 0, At, B0); PG8_MMA(0, 1, At, B1); PG8_BAR; PG8_SCHED;
            PG8_LDA(At, 1, 1); PG8_STAGE(PG8_SB(1, 0), b3, voffB); PG8_STAGE(PG8_SB(1, 1), b3 + hstep, voffB); PG8_STAGE(PG8_SA(1, 0), a3, voffA);
            PG8_WAIT_V(8); PG8_WAIT_L(0); PG8_BAR; PG8_MMA(1, 0, At, B0); PG8_MMA(1, 1, At, B1); PG8_BAR; PG8_SCHED;
            } else {
            PG8_LDB(B0, 0, 0); PG8_SCHED; PG8_LDA(At, 0, 0); PG8_STAGE(PG8_SA(1, 1), a1 + hstep, voffA);
            PG8_WAIT_L(8); PG8_BAR; PG8_WAIT_L(0); PG8_MMA(0, 0, At, B0); PG8_BAR; PG8_SCHED;
            PG8_LDB(B1, 0, 1); PG8_STAGE(PG8_SB(0, 0), b2, voffB);
            PG8_BAR; PG8_WAIT_L(0); PG8_MMA(0, 1, At, B1); PG8_BAR;
            PG8_LDA(At, 0, 1); PG8_STAGE(PG8_SA(0, 0), a2, voffA);
            PG8_BAR; PG8_WAIT_L(0); PG8_MMA(1, 0, At, B0); PG8_BAR; PG8_SCHED;
            PG8_STAGE(PG8_SB(0, 1), b2 + hstep, voffB);
            PG8_WAIT_V(6); PG8_BAR; PG8_MMA(1, 1, At, B1); PG8_BAR;
            PG8_LDB(B0, 1, 0); PG8_SCHED; PG8_LDA(At, 1, 0); PG8_STAGE(PG8_SA(0, 1), a2 + hstep, voffA);
            PG8_WAIT_L(8); PG8_BAR; PG8_WAIT_L(0); PG8_MMA(0, 0, At, B0); PG8_BAR; PG8_SCHED;
            PG8_LDB(B1, 1, 1); PG8_STAGE(PG8_SB(1, 0), b3, voffB);
            PG8_BAR; PG8_WAIT_L(0); PG8_MMA(0, 1, At, B1); PG8_BAR;
            PG8_LDA(At, 1, 1); PG8_STAGE(PG8_SA(1, 0), a3, voffA);
            PG8_BAR; PG8_WAIT_L(0); PG8_MMA(1, 0, At, B0); PG8_BAR; PG8_SCHED;
            PG8_STAGE(PG8_SB(1, 1), b3 + hstep, voffB);
            PG8_WAIT_V(6); PG8_BAR; PG8_MMA(1, 1, At, B1); PG8_BAR;
            }
        }
        if constexpr (ALIGN_EPI) { if (wr == 0) PG8_BAR; }
        if constexpr (!Epi::AFTER_DRAIN) { E(acc, cur, wr, wc, fr, fq); S.done(cur); }
        if (!has_next) break;
        bool keep_acc = false;
        if constexpr (Epi::CHAIN) keep_acc = E.keep(cur);
        if (!keep_acc) {
#pragma unroll
        for (int a = 0; a < 2; ++a)
#pragma unroll
            for (int b = 0; b < 2; ++b)
#pragma unroll
                for (int m = 0; m < 4; ++m)
#pragma unroll
                    for (int n = 0; n < 2; ++n) acc[a][b][m][n] = (f32x4){0.f, 0.f, 0.f, 0.f};
        }
        cur = nxt; cA = nA; cB = nB; ++ui;
        if constexpr (ALIGN_EPI) { if (wr == 1) PG8_BAR; }
    }
    PG8_WAIT_V(0);
    if constexpr (!ALIGN_EPI) { if (wr == 0) PG8_BAR; }
    PG8_BAR;
    if constexpr (Epi::AFTER_DRAIN) { E.fused(acc, cur, wr, wc, fr, fq, lds, wid, lane); S.done(cur); }
#undef PG8_SA
#undef PG8_SB
#undef PG8_STAGE
#undef PG8_LDA
#undef PG8_LDB
#undef PG8_MMA
#undef PG8_WAIT_V
#undef PG8_WAIT_L
#undef PG8_BAR
#undef PG8_SCHED
}
}
#ifndef PG8_SP2
#define PG8_SP2 true
#endif
#ifndef PG8_ALIGN
#define PG8_ALIGN true
#endif

#define LAS __attribute__((address_space(3)))
typedef unsigned short bf16;
typedef float f32x4 __attribute__((ext_vector_type(4)));
typedef unsigned v4u __attribute__((ext_vector_type(4)));
typedef unsigned v2u __attribute__((ext_vector_type(2)));

constexpr int T_ALL = 32768, TH = 16384, D = 1024, SEQ = 4096, NB_H = 4  ;
constexpr int ZLD = 3584, GLD = 3072, ULD = 5632, FF = 2816;
constexpr int C_HQ = 0, C_HF = 512, C_HG = 1024, C_SQ = 1536, C_SK = 2048, C_DQ = 2560, C_DK = 3072, C_HI = 3584, C_SV = 4096, C_DV = 4608;
constexpr float RMS_EPS = 1e-6f;
constexpr int LDS_BYTES = 135168;

constexpr size_t MiB = 1u << 20;
constexpr size_t WS_SSQ = 0;
constexpr size_t WS_BAR = 1536 * 1024;
constexpr size_t WS_WIN = 2 * MiB;
constexpr size_t WS_WUP = WS_WIN + 32 * MiB;
constexpr size_t WS_WDN = WS_WUP + 22 * MiB;
constexpr size_t WS_WOUT = WS_WDN + 11 * MiB;
constexpr size_t WS_WBR = WS_WOUT + 4 * MiB;
constexpr size_t WS_XB = WS_WBR + 6 * MiB;
constexpr size_t WS_OBR = WS_XB + 64 * MiB;
constexpr size_t WS_ST = WS_OBR + 48 * MiB;
constexpr size_t WS_ZT = WS_ST + 32 * MiB;
constexpr size_t WS_R1 = WS_ZT + 48 * MiB;
constexpr size_t WS_ZMAIN = WS_R1, WS_GATES = WS_R1 + 112 * MiB;
constexpr size_t WS_MB = WS_R1;
constexpr size_t WS_HALO = WS_R1, WS_ACT = WS_R1 + 24 * MiB;
constexpr size_t WS_DEC = WS_R1 + 208 * MiB;
constexpr size_t WS_END = WS_DEC + 1 * MiB;
static_assert(WS_END <= 512 * MiB, "workspace map");

struct Args { const float* in[18]; float* out; unsigned char* ws; int ph_lo, ph_hi; };
typedef const __attribute__((address_space(4))) Args* KArgP;
struct KA {
    KArgP p;
    __device__ __forceinline__ const float* in(int i) const { return p->in[i]; }
    __device__ __forceinline__ float* out() const { return p->out; }
    __device__ __forceinline__ unsigned char* ws() const { return p->ws; }
};
enum { I_X = 0, I_ANW, I_WIN, I_LB, I_HON, I_WHA, I_WSB, I_LAM, I_DON, I_WDA, I_RB, I_WOUT, I_FNW, I_WUP, I_CW, I_CB, I_WDN, I_FINW };

__device__ __forceinline__ float bf2f(bf16 b) { return __uint_as_float((unsigned)b << 16); }
__device__ __forceinline__ float blo(unsigned w) { return __uint_as_float(w << 16); }
__device__ __forceinline__ float bhi(unsigned w) { return __uint_as_float(w & 0xffff0000u); }
__device__ __forceinline__ unsigned pk2(float lo, float hi) { unsigned r; asm("v_cvt_pk_bf16_f32 %0, %1, %2" : "=v"(r) : "v"(lo), "v"(hi)); return r; }
__device__ __forceinline__ unsigned f2bf(float f) { return pk2(f, 0.f) & 0xffffu; }
__device__ __forceinline__ float wave_sum(float v) {
#pragma unroll
    for (int o = 1; o < 64; o <<= 1) v += __shfl_xor(v, o);
    return v;
}
__device__ __forceinline__ float sigm(float x) { return __builtin_amdgcn_rcpf(1.0f + __expf(-x)); }

__device__ __forceinline__ void transpose_item(const float* W, int srcN, int k0, int srcn0, const float* scale, bf16* WT, int K, int dstn0, LAS float* scr, int lane) {
    {
        const int kr = lane >> 3, c4 = (lane & 7) * 4;
        f32x4 v[8]; float scv[8];
#pragma unroll
        for (int i = 0; i < 8; ++i) { v[i] = *(const f32x4*)(W + (size_t)(k0 + 8 * i + kr) * srcN + srcn0 + c4); scv[i] = scale ? scale[k0 + 8 * i + kr] : 1.0f; }
#pragma unroll
        for (int i = 0; i < 8; ++i) {
            const int kk = 8 * i + kr; const float sc = scv[i];
            scr[kk * 33 + c4] = v[i][0] * sc; scr[kk * 33 + c4 + 1] = v[i][1] * sc; scr[kk * 33 + c4 + 2] = v[i][2] * sc; scr[kk * 33 + c4 + 3] = v[i][3] * sc;
        }
    }
    asm volatile("s_waitcnt lgkmcnt(0)" ::: "memory");
    const int c = lane & 7;
#pragma unroll
    for (int j = 0; j < 4; ++j) { const int n = (lane >> 3) + 8 * j; const LAS float* s = scr + (8 * c) * 33 + n;
        v4u o; o.x = pk2(s[0 * 33], s[1 * 33]); o.y = pk2(s[2 * 33], s[3 * 33]); o.z = pk2(s[4 * 33], s[5 * 33]); o.w = pk2(s[6 * 33], s[7 * 33]);
        *(v4u*)(WT + (size_t)(dstn0 + n) * K + k0 + 8 * c) = o; }
    asm volatile("s_waitcnt lgkmcnt(0)" ::: "memory");
}
__device__ __forceinline__ int win_src_col(int n) {
    if (n >= 3584 && n < 6656) return 5120 + (n - 3584);
    const int g = (n < 3584) ? (n >> 9) : 7 + ((n - 6656) >> 9), r = n & 511;
    const int sg = (g == 0) ? 0 : (g == 1) ? 1 : (g == 2) ? 3 : (g == 3) ? 4 : (g == 4) ? 5 : (g == 5) ? 7 : (g == 6) ? 8 : (g == 7) ? 2 : (g == 8) ? 6 : 9;
    return sg * 512 + r;
}
__device__ __forceinline__ void phase_prep(const KA& a, LAS unsigned char* lds) {
    const int tid = opq_tid(), lane = tid & 63, wave = tid >> 6;
    const int gw = opq_bid() * 8 + wave, NGW = gridDim.x * 8;
    LAS float* scr = (LAS float*)(lds + wave * 8704);
    unsigned char* ws = a.ws();
    constexpr int N_IN = 16 * 256, N_UP = 16 * 176, N_DN = 44 * 32, N_OUT = 16 * 32, N_BR = 8 * 32, PER_L = N_IN + N_UP + N_DN + N_OUT + 3 * N_BR;
    for (int it = gw; it < 2 * PER_L; it += NGW) {
        const int l = it / PER_L; int r = it % PER_L;
        if (r < N_IN) { const int kb = r / 256, nb = r % 256; transpose_item(a.in(I_WIN) + (size_t)l * 1024 * 8192, 8192, kb * 64, win_src_col(nb * 32), a.in(I_ANW) + l * 1024, (bf16*)(ws + WS_WIN) + (size_t)l * 8192 * 1024, 1024, nb * 32, scr, lane); continue; }
        r -= N_IN;
        if (r < N_UP) { const int kb = r / 176, nb = r % 176; const int n0 = nb * 32, j = n0 >> 8, rr = n0 & 255; const int sc = (rr < 128) ? (j * 128 + rr) : (FF + j * 128 + rr - 128);
            transpose_item(a.in(I_WUP) + (size_t)l * 1024 * ULD, ULD, kb * 64, sc, a.in(I_FNW) + l * 1024, (bf16*)(ws + WS_WUP) + (size_t)l * ULD * 1024, 1024, n0, scr, lane); continue; }
        r -= N_UP;
        if (r < N_DN) { const int kb = r / 32, nb = r % 32; transpose_item(a.in(I_WDN) + (size_t)l * FF * 1024, 1024, kb * 64, nb * 32, nullptr, (bf16*)(ws + WS_WDN) + (size_t)l * 1024 * FF, FF, nb * 32, scr, lane); continue; }
        r -= N_DN;
        if (r < N_OUT) { const int kb = r / 32, nb = r % 32; transpose_item(a.in(I_WOUT) + (size_t)l * 1024 * 1024, 1024, kb * 64, nb * 32, nullptr, (bf16*)(ws + WS_WOUT) + (size_t)l * 1024 * 1024, 1024, nb * 32, scr, lane); continue; }
        r -= N_OUT;
        const int br = r / N_BR; r %= N_BR; const int kb = r / 32, nb = r % 32;
        const float* src = (br == 0 ? a.in(I_WHA) : br == 1 ? a.in(I_WSB) : a.in(I_WDA)) + (size_t)l * 512 * 1024;
        transpose_item(src, 1024, kb * 64, nb * 32, nullptr, (bf16*)(ws + WS_WBR) + (size_t)(l * 3 + br) * 1024 * 512, 512, nb * 32, scr, lane);
    }
}
__device__ __forceinline__ void phase_xprep(const KA& a, int half) {
    const int tid = opq_tid(), lane = tid & 63, wave = tid >> 6;
    const int gw = opq_bid() * 8 + wave, NGW = gridDim.x * 8;
    ssq_t* ssq = (ssq_t*)(a.ws() + WS_SSQ);
    bf16* xb = (bf16*)(a.ws() + WS_XB) + (size_t)half * TH * D;
    for (int r0 = gw * 4; r0 < TH; r0 += NGW * 4) {
        f32x4 v[4][4];
#pragma unroll
        for (int q = 0; q < 4; ++q) { const f32x4* xr = (const f32x4*)(a.in(I_X) + (size_t)(half * TH + r0 + q) * D) + lane;
#pragma unroll
            for (int j = 0; j < 4; ++j) v[q][j] = xr[64 * j]; }
#pragma unroll
        for (int q = 0; q < 4; ++q) {
            const int r = r0 + q;
            v2u* o8 = (v2u*)(xb + (size_t)r * D) + lane;
            float s = 0.f;
#pragma unroll
            for (int j = 0; j < 4; ++j) { const f32x4 x = v[q][j]; s += (x[0] * x[0] + x[1] * x[1]) + (x[2] * x[2] + x[3] * x[3]); v2u w; w.x = pk2(x[0], x[1]); w.y = pk2(x[2], x[3]); o8[64 * j] = w; }
            s = wave_sum(s);
            if (lane == 0) ssq[(size_t)half * TH + r] = ssq_q(s);
            if (lane >= 1 && lane <= 4) ssq[(size_t)lane * T_ALL + (size_t)half * TH + r] = 0ull;
        }
    }
}

__device__ __forceinline__ void conv_fixup_tile(const KA& a, int l, int pm) {
    const bf16* halo = (const bf16*)(a.ws() + WS_HALO); bf16* act = (bf16*)(a.ws() + WS_ACT);
    const float* cw = a.in(I_CW) + (size_t)l * 3 * ULD; const float* cb = a.in(I_CB) + (size_t)l * ULD;
    for (int it = opq_tid(); it < 4 * (FF / 8); it += 512) {
        const int gl = it / (FF / 8), cgp = it % (FF / 8), c0 = cgp * 8, j = c0 >> 7, r = c0 & 127, gcol = j * 256 + r, vcol = gcol + 128;
        const int g = pm * 4 + gl, row = g * 64;
        float uu[4][2][8];
        const bool first = (row & (SEQ - 1)) == 0;
#pragma unroll
        for (int q = 0; q < 4; ++q) {
            const bf16* hp = (q < 2) ? halo + ((size_t)(g - 1) * 4 + 2 + q) * ULD : halo + ((size_t)g * 4 + (q - 2)) * ULD;
            v4u ag = {0u, 0u, 0u, 0u}, av = {0u, 0u, 0u, 0u};
            if (q >= 2 || !first) { ag = *(const v4u*)(hp + gcol); av = *(const v4u*)(hp + vcol); }
#pragma unroll
            for (int e = 0; e < 4; ++e) { uu[q][0][2 * e] = blo(ag[e]); uu[q][0][2 * e + 1] = bhi(ag[e]); uu[q][1][2 * e] = blo(av[e]); uu[q][1][2 * e + 1] = bhi(av[e]); }
        }
        float wg[3][8], wv[3][8], bgv[8], bvv[8];
#pragma unroll
        for (int k = 0; k < 3; ++k)
#pragma unroll
            for (int e4 = 0; e4 < 2; ++e4) { const f32x4 g4 = *(const f32x4*)(cw + k * ULD + c0 + 4 * e4), v4 = *(const f32x4*)(cw + k * ULD + FF + c0 + 4 * e4);
#pragma unroll
                for (int e = 0; e < 4; ++e) { wg[k][4 * e4 + e] = g4[e]; wv[k][4 * e4 + e] = v4[e]; } }
#pragma unroll
        for (int e4 = 0; e4 < 2; ++e4) { const f32x4 g4 = *(const f32x4*)(cb + c0 + 4 * e4), v4 = *(const f32x4*)(cb + FF + c0 + 4 * e4);
#pragma unroll
            for (int e = 0; e < 4; ++e) { bgv[4 * e4 + e] = g4[e]; bvv[4 * e4 + e] = v4[e]; } }
#pragma unroll
        for (int rr = 0; rr < 2; ++rr) {
            float o[8];
#pragma unroll
            for (int e = 0; e < 8; ++e) {
                const float gg = bgv[e] + wg[0][e] * uu[rr][0][e] + wg[1][e] * uu[rr + 1][0][e] + wg[2][e] * uu[rr + 2][0][e];
                const float vv = bvv[e] + wv[0][e] * uu[rr][1][e] + wv[1][e] * uu[rr + 1][1][e] + wv[2][e] * uu[rr + 2][1][e];
                o[e] = gg * sigm(gg) * vv;
            }
            v4u w; w.x = pk2(o[0], o[1]); w.y = pk2(o[2], o[3]); w.z = pk2(o[4], o[5]); w.w = pk2(o[6], o[7]);
            *(v4u*)(act + (size_t)(row + rr) * FF + c0) = w;
        }
    }
}

__device__ __forceinline__ void phase_final(const KA& a) {
    const int tid_ = opq_tid(); const int lane = tid_ & 63, gw = opq_bid() * 8 + (tid_ >> 6), NGW = gridDim.x * 8;
    const ssq_t* ssq = (const ssq_t*)(a.ws() + WS_SSQ);
    const f32x4* w4 = (const f32x4*)a.in(I_FINW) + lane;
    f32x4 wv[4];
#pragma unroll
    for (int j = 0; j < 4; ++j) wv[j] = w4[64 * j];
    const bf16* xb = (const bf16*)(a.ws() + WS_XB);
    for (int row0 = gw * 4; row0 < T_ALL; row0 += NGW * 4) {
        v2u v[4][4]; ssq_t sq[4];
#pragma unroll
        for (int q = 0; q < 4; ++q) { const v2u* xr = (const v2u*)(xb + (size_t)(row0 + q) * D) + lane; sq[q] = ssq[(size_t)4 * T_ALL + row0 + q];
#pragma unroll
            for (int j = 0; j < 4; ++j) v[q][j] = xr[64 * j]; }
#pragma unroll
        for (int q = 0; q < 4; ++q) {
            const float rs = rsqrtf(ssq_f(sq[q]) * (1.0f / 1024.0f) + RMS_EPS);
            f32x4* xr = (f32x4*)(a.out() + (size_t)(row0 + q) * D) + lane;
#pragma unroll
            for (int j = 0; j < 4; ++j) { const f32x4 x = {blo(v[q][j].x), bhi(v[q][j].x), blo(v[q][j].y), bhi(v[q][j].y)}; xr[64 * j] = x * rs * wv[j]; }
        }
    }
}

typedef short bf16x8 __attribute__((ext_vector_type(8)));
typedef _Float16 f16x8 __attribute__((ext_vector_type(8)));
typedef float f32x16 __attribute__((ext_vector_type(16)));
__device__ __forceinline__ unsigned cvtpk(float lo, float hi) { unsigned r; asm("v_cvt_pk_bf16_f32 %0, %1, %2" : "=v"(r) : "v"(lo), "v"(hi)); return r; }
__device__ __forceinline__ bf16x8 pack8(const f32x16& x, int o) {
    v4u w; w.x = cvtpk(x[o], x[o + 1]); w.y = cvtpk(x[o + 2], x[o + 3]); w.z = cvtpk(x[o + 4], x[o + 5]); w.w = cvtpk(x[o + 6], x[o + 7]);
    return __builtin_bit_cast(bf16x8, w);
}
__device__ __forceinline__ bf16x8 scale_bf8(v4u w, float sc) {
    v4u o;
#pragma unroll
    for (int e = 0; e < 4; ++e) o[e] = cvtpk(blo(w[e]) * sc, bhi(w[e]) * sc);
    return __builtin_bit_cast(bf16x8, o);
}
constexpr float LOG2E = 1.4426950408889634f;
__device__ __forceinline__ float max3f(float a, float b, float c) { float r; asm("v_max3_f32 %0, %1, %2, %3" : "=v"(r) : "v"(a), "v"(b), "v"(c)); return r; }
constexpr int KSTR = 144;

__device__ __forceinline__ void sb_mfma_unit(const KA& a, int b, int h, int qb, LAS unsigned char* lds) {
    const int tid = opq_tid(), lane = tid & 63, w = tid >> 6, r32 = lane & 31, hf = lane >> 5;
    const bf16* z = (const bf16*)(a.ws() + WS_ZMAIN);
    const bf16* zT = (const bf16*)(a.ws() + WS_ZT);
    bf16* ob = (bf16*)(a.ws() + WS_OBR) + (size_t)TH * 512;
    const int tq = qb * 256 + 32 * w + r32;
    const int ktmax = qb * 4 + 3, ktw = qb * 4 + (w >> 1);
    const int lrow = tid >> 3, lch = tid & 7;
    const bf16* kg = z + (size_t)(b * SEQ + lrow) * ZLD + C_SK + h * 64 + lch * 8;
    const bf16* vg = zT + (size_t)(512 + h * 64 + lrow) * TH + b * SEQ + lch * 8;
    const int lofs = lrow * KSTR + lch * 16;
    const v4u pkv = *(const v4u*)(kg + (size_t)ktmax * 64 * ZLD), pvv = *(const v4u*)(vg + ktmax * 64);
    bf16x8 qf[4];
#pragma unroll
    for (int st = 0; st < 4; ++st) qf[st] = __builtin_bit_cast(bf16x8, *(const v4u*)(z + (size_t)(b * SEQ + tq) * ZLD + C_SQ + h * 64 + 16 * st + 8 * hf));
#pragma unroll
    for (int st = 0; st < 4; ++st) qf[st] = scale_bf8(__builtin_bit_cast(v4u, qf[st]), 0.125f * LOG2E);
    f16x8 U[2], ones;
#pragma unroll
    for (int st = 0; st < 2; ++st)
#pragma unroll
        for (int j = 0; j < 8; ++j) { const int jj = 16 * st + 8 * (j >> 2) + 4 * hf + (j & 3); U[st][j] = (jj >= r32) ? (_Float16)1.0f : (_Float16)0.0f; }
#pragma unroll
    for (int j = 0; j < 8; ++j) ones[j] = (_Float16)1.0f;
    f32x16 o0, o1;
#pragma unroll
    for (int i = 0; i < 16; ++i) { o0[i] = 0.f; o1[i] = 0.f; }
    float R = 0.f; int done = 0;
    __syncthreads();
    *(LAS v4u*)(lds + lofs) = pkv; *(LAS v4u*)(lds + 9216 + lofs) = pvv;
    __syncthreads();
    for (int kt = ktmax; kt >= 0; --kt) {
        const int cur = (ktmax - kt) & 1;
        LAS unsigned char* Kb = lds + cur * 18432; LAS unsigned char* Vb = Kb + 9216;
        v4u kv, vv;
        if (kt > 0) { kv = *(const v4u*)(kg + (size_t)(kt - 1) * 64 * ZLD); vv = *(const v4u*)(vg + (kt - 1) * 64); }
        if (kt <= ktw) {
            f32x16 s0, s1;
#pragma unroll
            for (int i = 0; i < 16; ++i) { s0[i] = 0.f; s1[i] = 0.f; }
#pragma unroll
            for (int st = 0; st < 4; ++st) {
                const bf16x8 k0 = *(const LAS bf16x8*)(Kb + r32 * KSTR + st * 32 + hf * 16), k1 = *(const LAS bf16x8*)(Kb + (32 + r32) * KSTR + st * 32 + hf * 16);
                s0 = __builtin_amdgcn_mfma_f32_32x32x16_bf16(k0, qf[st], s0, 0, 0, 0);
                s1 = __builtin_amdgcn_mfma_f32_32x32x16_bf16(k1, qf[st], s1, 0, 0, 0);
            }
            const bool diag = (kt == ktw);
            const int kbase = kt * 64 + 4 * hf;
            f32x16 l0, l1;
            if (!diag) {
#pragma unroll
                for (int r = 0; r < 16; ++r) {
                    { const float zz = s0[r]; const float e = __builtin_amdgcn_exp2f(-fabsf(zz)); l0[r] = -(fmaxf(zz, 0.f) + __builtin_amdgcn_logf(1.0f + e)); }
                    { const float zz = s1[r]; const float e = __builtin_amdgcn_exp2f(-fabsf(zz)); l1[r] = -(fmaxf(zz, 0.f) + __builtin_amdgcn_logf(1.0f + e)); }
                }
            } else {
#pragma unroll
                for (int r = 0; r < 16; ++r) {
                    const int krow = (r & 3) + 8 * (r >> 2);
                    { const float zz = s0[r]; const float e = __builtin_amdgcn_exp2f(-fabsf(zz)); const float l = -(fmaxf(zz, 0.f) + __builtin_amdgcn_logf(1.0f + e)); l0[r] = (kbase + krow < tq) ? l : 0.f; }
                    { const float zz = s1[r]; const float e = __builtin_amdgcn_exp2f(-fabsf(zz)); const float l = -(fmaxf(zz, 0.f) + __builtin_amdgcn_logf(1.0f + e)); l1[r] = (kbase + 32 + krow < tq) ? l : 0.f; }
                }
            }
            f16x8 lf00, lf01, lf10, lf11;
#pragma unroll
            for (int j = 0; j < 8; ++j) { lf00[j] = (_Float16)l0[j]; lf01[j] = (_Float16)l0[8 + j]; lf10[j] = (_Float16)l1[j]; lf11[j] = (_Float16)l1[8 + j]; }
            f32x16 zero;
#pragma unroll
            for (int i = 0; i < 16; ++i) zero[i] = 0.f;
            f32x16 T = __builtin_amdgcn_mfma_f32_32x32x16_f16(ones, lf10, zero, 0, 0, 0);
            T = __builtin_amdgcn_mfma_f32_32x32x16_f16(ones, lf11, T, 0, 0, 0);
            f32x16 c1 = __builtin_amdgcn_mfma_f32_32x32x16_f16(U[0], lf10, zero, 0, 0, 0);
            c1 = __builtin_amdgcn_mfma_f32_32x32x16_f16(U[1], lf11, c1, 0, 0, 0);
            f32x16 c0 = __builtin_amdgcn_mfma_f32_32x32x16_f16(U[0], lf00, T, 0, 0, 0);
            c0 = __builtin_amdgcn_mfma_f32_32x32x16_f16(U[1], lf01, c0, 0, 0, 0);
            if (!diag) {
#pragma unroll
                for (int r = 0; r < 16; ++r) { s0[r] = __builtin_amdgcn_exp2f(s0[r] + c0[r] + R); s1[r] = __builtin_amdgcn_exp2f(s1[r] + c1[r] + R); }
            } else {
#pragma unroll
                for (int r = 0; r < 16; ++r) {
                    const int krow = (r & 3) + 8 * (r >> 2);
                    const float w0 = __builtin_amdgcn_exp2f(s0[r] + c0[r] + R), w1 = __builtin_amdgcn_exp2f(s1[r] + c1[r] + R);
                    s0[r] = (kbase + krow < tq) ? w0 : 0.f; s1[r] = (kbase + 32 + krow < tq) ? w1 : 0.f;
                }
            }
            R += __shfl(c0[0], r32);
            done = __all(R < -60.0f);
            const bf16x8 p00 = pack8(s0, 0), p01 = pack8(s0, 8), p10 = pack8(s1, 0), p11 = pack8(s1, 8);
#pragma unroll
            for (int mb = 0; mb < 2; ++mb) {
                const LAS unsigned char* vr = Vb + (32 * mb + r32) * KSTR + 8 * hf;
                f32x16& oo = mb ? o1 : o0;
#pragma unroll
                for (int kb = 0; kb < 2; ++kb)
#pragma unroll
                    for (int st = 0; st < 2; ++st) {
                        const v2u lo = *(const LAS v2u*)(vr + (32 * kb + 16 * st) * 2), hi = *(const LAS v2u*)(vr + (32 * kb + 16 * st + 8) * 2);
                        v4u av; av.x = lo.x; av.y = lo.y; av.z = hi.x; av.w = hi.y;
                        const bf16x8 pf = kb ? (st ? p11 : p10) : (st ? p01 : p00);
                        oo = __builtin_amdgcn_mfma_f32_32x32x16_bf16(__builtin_bit_cast(bf16x8, av), pf, oo, 0, 0, 0);
                    }
            }
        }
        if (kt > 0) { LAS unsigned char* nb = lds + (cur ^ 1) * 18432; *(LAS v4u*)(nb + lofs) = kv; *(LAS v4u*)(nb + 9216 + lofs) = vv; }
        {
            LAS int* fl = (LAS int*)(lds + 36864) + (((ktmax - kt) & 1) << 3);
            if (lane == 0) fl[w] = done ? 1 : 0;
            __syncthreads();
            const v4u f0 = *(const LAS v4u*)fl, f1 = *(const LAS v4u*)(fl + 4);
            if ((f0.x & f0.y & f0.z & f0.w & f1.x & f1.y & f1.z & f1.w) != 0u) break;
        }
    }
    bf16* orow = ob + (size_t)(b * SEQ + tq) * 512 + h * 64 + 4 * hf;
    float one_ = 1.0f; asm volatile("" : "+v"(one_));
#pragma unroll
    for (int i = 0; i < 16; ++i) { o0[i] *= one_; o1[i] *= one_; }
#pragma unroll
    for (int g = 0; g < 4; ++g) {
        v2u w0; w0.x = cvtpk(o0[4 * g], o0[4 * g + 1]); w0.y = cvtpk(o0[4 * g + 2], o0[4 * g + 3]); *(v2u*)(orow + 8 * g) = w0;
        v2u w1; w1.x = cvtpk(o1[4 * g], o1[4 * g + 1]); w1.y = cvtpk(o1[4 * g + 2], o1[4 * g + 3]); *(v2u*)(orow + 32 + 8 * g) = w1;
    }
}
constexpr int DKSTR = 272;
__device__ __forceinline__ void diff_mfma_unit(const KA& a, int l, int b, int h, int qb, LAS unsigned char* lds) {
    const int tid = opq_tid(), lane = tid & 63, w = tid >> 6, r32 = lane & 31, hf = lane >> 5, qg = w >> 1, map = w & 1;
    const bf16* z = (const bf16*)(a.ws() + WS_ZMAIN);
    const bf16* zT = (const bf16*)(a.ws() + WS_ZT);
    bf16* oc = (bf16*)(a.ws() + WS_OBR) + (size_t)2 * TH * 512;
    constexpr int VSTR = 144;
    constexpr int STAGE = 64 * DKSTR + 128 * VSTR;
    LAS float* lut = (LAS float*)(lds + 2 * STAGE); LAS float* lamp = lut + 200;
    const int t0w = qb * 128 + 32 * qg, tq = t0w + r32;
    const int krow = tid >> 4, kch = tid & 15;
    const int vrow = tid >> 3, vch = tid & 7;
    const bf16* kg = z + (size_t)(b * SEQ + krow) * ZLD + C_DK + h * 128 + kch * 8;
    const bf16* vg = zT + (size_t)(1024 + h * 128 + vrow) * TH + b * SEQ + vch * 8;
    float rbv = 0.f, lm0 = 0.f, lm1 = 0.f, lm2 = 0.f, lm3 = 0.f;
    if (tid >= 64 && tid <= 192) {
        const int dd = tid - 64; int bucket;
        if (dd < 16) bucket = dd; else { const int lg = 16 + (int)(logf((float)dd / 16.0f) / logf(8.0f) * 16.0f); bucket = lg < 31 ? lg : 31; }
        rbv = a.in(I_RB)[bucket * 4 + h];
    }
    if (tid >= 192 && tid < 256) { const int i = tid - 192; const float* lm = a.in(I_LAM) + l * 256; lm0 = lm[i]; lm1 = lm[64 + i]; lm2 = lm[128 + i]; lm3 = lm[192 + i]; }
    bf16x8 qf[4];
#pragma unroll
    for (int st = 0; st < 4; ++st) qf[st] = __builtin_bit_cast(bf16x8, *(const v4u*)(z + (size_t)(b * SEQ + tq) * ZLD + C_DQ + h * 128 + map * 64 + 16 * st + 8 * hf));
    const v4u pk0 = *(const v4u*)(kg), pk1 = *(const v4u*)(kg + (size_t)32 * ZLD), pv0 = *(const v4u*)(vg), pv1 = *(const v4u*)(vg + (size_t)64 * TH);
    __syncthreads();
    if (tid <= 192) lut[tid] = (tid < 64) ? -INFINITY : rbv * LOG2E;
    if (tid >= 192 && tid < 256) {
        const float s1 = wave_sum(lm0 * lm1), s2 = wave_sum(lm2 * lm3);
        int lo_ = l; asm volatile("" : "+s"(lo_));
        const float lam_init = (lo_ == 0) ? 0.2f : (0.8f - 0.6f * 0.7408182206817179f);
        if (tid == 192) { lamp[0] = expf(s1) - expf(s2) + lam_init; lamp[1] = 1.0f - lam_init; }
    }
#pragma unroll
    for (int st = 0; st < 4; ++st) qf[st] = scale_bf8(__builtin_bit_cast(v4u, qf[st]), 0.125f * LOG2E);
    f32x16 o[4];
#pragma unroll
    for (int mb = 0; mb < 4; ++mb)
#pragma unroll
        for (int i = 0; i < 16; ++i) o[mb][i] = 0.f;
    float mx = -INFINITY, lsum = 0.f;
    const int ktmax = 2 * qb + 1, ktw = 2 * qb + (qg >> 1);
    const int kofs = krow * DKSTR + kch * 16, vofs = 64 * DKSTR + vrow * VSTR + (vch >> 1) * 32 + (vch & 1) * 8;
#define DF_STAGE_WRITE(nb, k0, k1, v0, v1) do { *(LAS v4u*)((nb) + kofs) = k0; *(LAS v4u*)((nb) + kofs + 32 * DKSTR) = k1; \
        *(LAS v2u*)((nb) + vofs) = (v2u){v0.x, v0.y}; *(LAS v2u*)((nb) + vofs + 16) = (v2u){v0.z, v0.w}; *(LAS v2u*)((nb) + vofs + 64 * VSTR) = (v2u){v1.x, v1.y}; *(LAS v2u*)((nb) + vofs + 64 * VSTR + 16) = (v2u){v1.z, v1.w}; } while (0)
#define DF_LDV(dst, ks) do { _Pragma("unroll") for (int mb = 0; mb < 4; ++mb) dst[mb] = *(const LAS v4u*)(vr + 32 * mb * VSTR + (ks) * 32); } while (0)
#define DF_MM(src, pf) do { _Pragma("unroll") for (int mb = 0; mb < 4; ++mb) o[mb] = __builtin_amdgcn_mfma_f32_32x32x16_bf16(__builtin_bit_cast(bf16x8, src[mb]), pf, o[mb], 0, 0, 0); } while (0)
    DF_STAGE_WRITE(lds, pk0, pk1, pv0, pv1);
    __syncthreads();
    const float bias_far = lut[192];
    float one_ = 1.0f; asm volatile("" : "+v"(one_));
    for (int kt = 0; kt <= ktmax; ++kt) {
        LAS unsigned char* Kb = lds + (kt & 1) * STAGE; LAS unsigned char* Vb = Kb + 64 * DKSTR;
        v4u k0, k1, v0, v1;
        if (kt < ktmax) { k0 = *(const v4u*)(kg + (size_t)(kt + 1) * 64 * ZLD); k1 = *(const v4u*)(kg + (size_t)((kt + 1) * 64 + 32) * ZLD); v0 = *(const v4u*)(vg + (kt + 1) * 64); v1 = *(const v4u*)(vg + (size_t)64 * TH + (kt + 1) * 64); }
        if (kt <= ktw) {
            const bool far = (t0w - (kt * 64 + 63)) >= 128;
            const float boff = far ? bias_far : 0.f;
            f32x16 s0, s1;
#pragma unroll
            for (int i = 0; i < 16; ++i) { s0[i] = 0.f; s1[i] = 0.f; }
            {
                bf16x8 ka[4], kb2[4];
#pragma unroll
                for (int st = 0; st < 4; ++st) { ka[st] = *(const LAS bf16x8*)(Kb + r32 * DKSTR + map * 128 + st * 32 + hf * 16); kb2[st] = *(const LAS bf16x8*)(Kb + (32 + r32) * DKSTR + map * 128 + st * 32 + hf * 16); }
                __builtin_amdgcn_s_setprio(1);
#pragma unroll
                for (int st = 0; st < 4; ++st) {
                    s0 = __builtin_amdgcn_mfma_f32_32x32x16_bf16(ka[st], qf[st], s0, 0, 0, 0);
                    s1 = __builtin_amdgcn_mfma_f32_32x32x16_bf16(kb2[st], qf[st], s1, 0, 0, 0);
                }
                __builtin_amdgcn_s_setprio(0);
            }
            if (!far) {
                const int kbase = kt * 64 + 4 * hf;
                float b0[16], b1[16];
#pragma unroll
                for (int r = 0; r < 16; ++r) {
                    const int kr = (r & 3) + 8 * (r >> 2);
                    const int d0 = tq - (kbase + kr);
                    b0[r] = lut[min(max(d0, -64), 128) + 64]; b1[r] = lut[min(max(d0 - 32, -64), 128) + 64];
                }
#pragma unroll
                for (int r = 0; r < 16; ++r) { s0[r] += b0[r]; s1[r] += b1[r]; }
            }
            const float s00 = s0[0] * one_, s10 = s1[0] * one_;
            float tmax = max3f(s00, s10, s0[1]);
#pragma unroll
            for (int r = 1; r < 15; ++r) tmax = max3f(tmax, s1[r], s0[r + 1]);
            tmax = fmaxf(tmax, s1[15]);
            tmax = fmaxf(tmax, __shfl_xor(tmax, 32)) + boff;
            if (__any(tmax - mx > 10.0f)) {
                const float mnew = fmaxf(mx, tmax), alpha = __builtin_amdgcn_exp2f(mx - mnew); mx = mnew; lsum *= alpha;
#pragma unroll
                for (int mb = 0; mb < 4; ++mb)
#pragma unroll
                    for (int i = 0; i < 16; ++i) o[mb][i] *= alpha;
            }
            const float cref = mx - boff;
            typedef float f32x2_ __attribute__((ext_vector_type(2)));
            f32x2_ ps2 = {0.f, 0.f};
#pragma unroll
            for (int r = 0; r < 16; r += 2) {
                f32x2_ a0 = {s0[r], s0[r + 1]}, a1 = {s1[r], s1[r + 1]};
                a0 = a0 - cref; a1 = a1 - cref;
                a0[0] = __builtin_amdgcn_exp2f(a0[0]); a0[1] = __builtin_amdgcn_exp2f(a0[1]); a1[0] = __builtin_amdgcn_exp2f(a1[0]); a1[1] = __builtin_amdgcn_exp2f(a1[1]);
                ps2 += a0; ps2 += a1;
                s0[r] = a0[0]; s0[r + 1] = a0[1]; s1[r] = a1[0]; s1[r + 1] = a1[1];
            }
            lsum += ps2[0] + ps2[1];
            const bf16x8 p00 = pack8(s0, 0), p01 = pack8(s0, 8), p10 = pack8(s1, 0), p11 = pack8(s1, 8);
            {
                const LAS unsigned char* vr = Vb + r32 * VSTR + 16 * hf; v4u avA[4], avB[4];
                __builtin_amdgcn_s_setprio(1);
                DF_LDV(avA, 0); DF_LDV(avB, 1); DF_MM(avA, p00); DF_LDV(avA, 2); DF_MM(avB, p01); DF_LDV(avB, 3); DF_MM(avA, p10); DF_MM(avB, p11);
                __builtin_amdgcn_sched_group_barrier(0x100, 8, 0); __builtin_amdgcn_sched_group_barrier(0x008, 4, 0); __builtin_amdgcn_sched_group_barrier(0x100, 4, 0);
                __builtin_amdgcn_sched_group_barrier(0x008, 4, 0); __builtin_amdgcn_sched_group_barrier(0x100, 4, 0); __builtin_amdgcn_sched_group_barrier(0x008, 8, 0);
                __builtin_amdgcn_s_setprio(0);
            }
        }
        if (kt < ktmax) { LAS unsigned char* nb = lds + ((kt + 1) & 1) * STAGE; DF_STAGE_WRITE(nb, k0, k1, v0, v1); }
        __syncthreads();
    }
#undef DF_STAGE_WRITE
#undef DF_LDV
#undef DF_MM
    lsum += __shfl_xor(lsum, 32);
    const float inv = 1.0f / lsum;
    const float lam = lamp[0], post = lamp[1];
    LAS float* ex = (LAS float*)lds + (size_t)qg * 4096 + lane;
    if (map == 1) {
#pragma unroll
        for (int mb = 0; mb < 4; ++mb)
#pragma unroll
            for (int i = 0; i < 16; ++i) ex[(mb * 16 + i) * 64] = o[mb][i] * inv;
    }
    __syncthreads();
    if (map == 0) {
        float ss = 0.f;
#pragma unroll
        for (int mb = 0; mb < 4; ++mb)
#pragma unroll
            for (int i = 0; i < 16; ++i) { const float res = o[mb][i] * inv - lam * ex[(mb * 16 + i) * 64]; o[mb][i] = res; ss += res * res; }
        ss += __shfl_xor(ss, 32);
        const float rs = rsqrtf(ss * (1.0f / 128.0f) + RMS_EPS) * post;
        const float* onw = a.in(I_DON) + l * 128;
        bf16* orow = oc + (size_t)(b * SEQ + tq) * 512 + h * 128 + 4 * hf;
        f32x4 nw[4][4];
#pragma unroll
        for (int mb = 0; mb < 4; ++mb)
#pragma unroll
            for (int g = 0; g < 4; ++g) nw[mb][g] = *(const f32x4*)(onw + 32 * mb + 8 * g + 4 * hf);
#pragma unroll
        for (int mb = 0; mb < 4; ++mb)
#pragma unroll
            for (int g = 0; g < 4; ++g) {
                v2u wv; wv.x = cvtpk(o[mb][4 * g] * rs * nw[mb][g][0], o[mb][4 * g + 1] * rs * nw[mb][g][1]); wv.y = cvtpk(o[mb][4 * g + 2] * rs * nw[mb][g][2], o[mb][4 * g + 3] * rs * nw[mb][g][3]);
                *(v2u*)(orow + 32 * mb + 8 * g) = wv;
            }
    }
}

struct HgGate { float cum[16]; float key[16]; float c15, c31, c47, last; };
__device__ __forceinline__ void hg_gates(HgGate& G, const KA& a, int l, int b, int h, int c, int tid, LAS float* segsum) {
    const int k = tid & 127, seg = tid >> 7;
    const bf16* z = (const bf16*)(a.ws() + WS_ZMAIN) + (size_t)(b * SEQ + c * 64 + seg * 16) * ZLD + C_HF + h * 128 + k;
    float lb = 0.f;
    if (l == 1) { const float a0 = a.in(I_LB)[h * 128 + k], a1 = a.in(I_LB)[512 + h * 128 + k]; lb = 1.0f / (1.0f + __expf(a0 - a1)); }
    float run = 0.f;
    bf16 zr[16];
#pragma unroll
    for (int i = 0; i < 16; ++i) zr[i] = z[(size_t)i * ZLD];
#pragma unroll
    for (int i = 0; i < 16; ++i) {
        const float zf = bf2f(zr[i]);
        const float e = __expf(-fabsf(zf));
        const float sp = __logf(1.0f + e);
        const float rc = __builtin_amdgcn_rcpf(1.0f + e); const float sg = (zf >= 0.f) ? rc : e * rc;
        float lf;
        if (l == 0) lf = -(fmaxf(-zf, 0.f) + sp);
        else lf = __logf(lb + (1.0f - lb) * sg);
        G.key[i] = (1.0f - lb) * (1.0f - sg);
        run += lf; G.cum[i] = run;
    }
    segsum[seg * 128 + k] = run;
    __syncthreads();
    const float s0 = segsum[k], s1 = segsum[128 + k], s2 = segsum[256 + k], s3 = segsum[384 + k];
    const float pre = (seg == 0) ? 0.f : (seg == 1) ? s0 : (seg == 2) ? (s0 + s1) : (s0 + s1 + s2);
#pragma unroll
    for (int i = 0; i < 16; ++i) G.cum[i] += pre;
    G.c15 = s0; G.c31 = s0 + s1; G.c47 = s0 + s1 + s2; G.last = s0 + s1 + s2 + s3;
}
__device__ __forceinline__ void hg_pass1_unit(const KA& a, int l, int ch, LAS unsigned char* lds) {
    const int tid = opq_tid(), lane = tid & 63, w = tid >> 6, r32 = lane & 31, hf = lane >> 5;
    const int c = ch & 63, h = (ch >> 6) & 3, b = ch >> 8;
    LAS float* segsum = (LAS float*)(lds + 18432);
    const int vb = w >> 1;
    const bf16* hiT = (const bf16*)(a.ws() + WS_ZT) + (size_t)(h * 128 + 32 * vb + r32) * TH + b * SEQ + c * 64 + 8 * hf;
    bf16x8 af[4];
#pragma unroll
    for (int st = 0; st < 4; ++st) af[st] = __builtin_bit_cast(bf16x8, *(const v4u*)(hiT + 16 * st));
    __syncthreads();
    HgGate G; hg_gates(G, a, l, b, h, c, tid, segsum);
    const int k = tid & 127, seg = tid >> 7;
    {
        v4u w0, w1;
#pragma unroll
        for (int e = 0; e < 4; ++e) {
            w0[e] = cvtpk(G.key[2 * e] * __expf(G.last - G.cum[2 * e]), G.key[2 * e + 1] * __expf(G.last - G.cum[2 * e + 1]));
            w1[e] = cvtpk(G.key[8 + 2 * e] * __expf(G.last - G.cum[8 + 2 * e]), G.key[9 + 2 * e] * __expf(G.last - G.cum[9 + 2 * e]));
        }
        *(LAS v4u*)(lds + k * KSTR + seg * 32) = w0; *(LAS v4u*)(lds + k * KSTR + seg * 32 + 16) = w1;
    }
    if (seg == 0) ((float*)(a.ws() + WS_DEC))[(size_t)ch * 128 + k] = __expf(G.last);
    __syncthreads();
    bf16* ST = (bf16*)(a.ws() + WS_ST) + (size_t)ch * 16384;
#pragma unroll
    for (int nn = 0; nn < 2; ++nn) {
        const int nb = 2 * (w & 1) + nn;
        f32x16 acc;
#pragma unroll
        for (int i = 0; i < 16; ++i) acc[i] = 0.f;
        bf16x8 bfr[4];
#pragma unroll
        for (int st = 0; st < 4; ++st) bfr[st] = *(const LAS bf16x8*)(lds + (32 * nb + r32) * KSTR + st * 32 + hf * 16);
        __builtin_amdgcn_s_setprio(1);
#pragma unroll
        for (int st = 0; st < 4; ++st) acc = __builtin_amdgcn_mfma_f32_32x32x16_bf16(af[st], bfr[st], acc, 0, 0, 0);
        __builtin_amdgcn_s_setprio(0);
        float one_ = 1.0f; asm volatile("" : "+v"(one_));
#pragma unroll
        for (int r = 0; r < 16; ++r) { const int v = 32 * vb + (r & 3) + 8 * (r >> 2) + 4 * hf; ST[(size_t)v * 128 + 32 * nb + r32] = (bf16)f2bf(acc[r] * one_); }
    }
}
__device__ __forceinline__ void hg_pass2(const KA& a) {
    const int gt = opq_bid() * 512 + opq_tid(), nthr = gridDim.x * 512;
    for (int it = gt; it < 16 * 8192; it += nthr) {
        const int bh = it >> 13, e2 = it & 8191;
        unsigned* ST = (unsigned*)(a.ws() + WS_ST) + (size_t)bh * 64 * 8192 + e2;
        const float* dec = (const float*)(a.ws() + WS_DEC) + (size_t)bh * 64 * 128 + 2 * (e2 & 63);
        float r0 = 0.f, r1 = 0.f;
#pragma unroll 1
        for (int cb = 0; cb < 64; cb += 32) {
            unsigned tv[32]; float d0[32], d1[32];
#pragma unroll
            for (int j = 0; j < 32; ++j) { tv[j] = ST[(size_t)(cb + j) * 8192]; d0[j] = dec[(cb + j) * 128]; d1[j] = dec[(cb + j) * 128 + 1]; }
#pragma unroll
            for (int j = 0; j < 32; ++j) {
                ST[(size_t)(cb + j) * 8192] = pk2(r0, r1);
                r0 = d0[j] * r0 + blo(tv[j]); r1 = d1[j] * r1 + bhi(tv[j]);
            }
        }
    }
}
constexpr int TSTR = 272;
__device__ __forceinline__ void hg_pass3_unit(const KA& a, int l, int ch, LAS unsigned char* lds) {
    const int tid = opq_tid(), lane = tid & 63, w = tid >> 6, r32 = lane & 31, hf = lane >> 5;
    const int c = ch & 63, h = (ch >> 6) & 3, b = ch >> 8;
    LAS unsigned char* QI = lds; LAS unsigned char* QD = lds + 64 * TSTR; LAS unsigned char* KD = lds + 128 * TSTR; LAS unsigned char* QO = lds + 192 * TSTR; LAS unsigned char* KO = lds + 224 * TSTR;
    LAS float* segsum = (LAS float*)(lds + 256 * TSTR); LAS float* part = segsum + 512;
    const int k = tid & 127, seg = tid >> 7, I = seg >> 1;
    const int vb = w >> 1, Iw = w & 1;
    bf16 qr[16];
    {
        const bf16* zq = (const bf16*)(a.ws() + WS_ZMAIN) + (size_t)(b * SEQ + c * 64 + seg * 16) * ZLD + C_HQ + h * 128 + k;
#pragma unroll
        for (int i = 0; i < 16; ++i) qr[i] = zq[(size_t)i * ZLD];
    }
    const bf16* STc = (const bf16*)(a.ws() + WS_ST) + (size_t)ch * 16384 + (size_t)(32 * vb + r32) * 128 + 8 * hf;
    v4u sa[8];
#pragma unroll
    for (int st = 0; st < 8; ++st) sa[st] = *(const v4u*)(STc + 16 * st);
    const bf16* hiT = (const bf16*)(a.ws() + WS_ZT) + (size_t)(h * 128 + 32 * vb + r32) * TH + b * SEQ + c * 64 + 4 * hf;
    v4u hD[2], hO[2];
#pragma unroll
    for (int st = 0; st < 2; ++st) {
        const v2u lo = *(const v2u*)(hiT + 32 * Iw + 16 * st), hi = *(const v2u*)(hiT + 32 * Iw + 16 * st + 8); hD[st] = (v4u){lo.x, lo.y, hi.x, hi.y};
        const v2u lo2 = *(const v2u*)(hiT + 16 * st), hi2 = *(const v2u*)(hiT + 16 * st + 8); hO[st] = (v4u){lo2.x, lo2.y, hi2.x, hi2.y};
    }
    const size_t orow_ = (size_t)(b * SEQ + c * 64 + 32 * Iw + r32);
    v2u gwv[4];
#pragma unroll
    for (int g = 0; g < 4; ++g) gwv[g] = *(const v2u*)((const bf16*)(a.ws() + WS_ZMAIN) + orow_ * ZLD + C_HG + h * 128 + 32 * vb + 4 * hf + 8 * g);
    __syncthreads();
    HgGate G; hg_gates(G, a, l, b, h, c, tid, segsum);
    {
        const float mI = I ? G.c47 : G.c15;
#pragma unroll
        for (int i = 0; i < 16; ++i) {
            const int t = seg * 16 + i;
            const float q = bf2f(qr[i]) * 0.08838834764831845f;
            *(LAS bf16*)(QI + t * TSTR + 2 * k) = (bf16)f2bf(q * __expf(G.cum[i]));
            *(LAS bf16*)(QD + t * TSTR + 2 * k) = (bf16)f2bf(q * __expf(G.cum[i] - mI));
            *(LAS bf16*)(KD + t * TSTR + 2 * k) = (bf16)f2bf(G.key[i] * __expf(mI - G.cum[i]));
            if (I) *(LAS bf16*)(QO + (t - 32) * TSTR + 2 * k) = (bf16)f2bf(q * __expf(G.cum[i] - G.c31));
            else   *(LAS bf16*)(KO + t * TSTR + 2 * k) = (bf16)f2bf(G.key[i] * __expf(G.c31 - G.cum[i]));
        }
    }
    __syncthreads();
    f32x16 sD, sO, o;
#pragma unroll
    for (int i = 0; i < 16; ++i) { sD[i] = 0.f; sO[i] = 0.f; o[i] = 0.f; }
#pragma unroll
    for (int st = 0; st < 8; ++st) {
        const bf16x8 kd = *(const LAS bf16x8*)(KD + (32 * Iw + r32) * TSTR + st * 32 + hf * 16), qd = *(const LAS bf16x8*)(QD + (32 * Iw + r32) * TSTR + st * 32 + hf * 16);
        sD = __builtin_amdgcn_mfma_f32_32x32x16_bf16(kd, qd, sD, 0, 0, 0);
        const bf16x8 qi = *(const LAS bf16x8*)(QI + (32 * Iw + r32) * TSTR + st * 32 + hf * 16);
        o = __builtin_amdgcn_mfma_f32_32x32x16_bf16(__builtin_bit_cast(bf16x8, sa[st]), qi, o, 0, 0, 0);
    }
    if (Iw) {
#pragma unroll
        for (int st = 0; st < 8; ++st) {
            const bf16x8 ko = *(const LAS bf16x8*)(KO + r32 * TSTR + st * 32 + hf * 16), qo = *(const LAS bf16x8*)(QO + r32 * TSTR + st * 32 + hf * 16);
            sO = __builtin_amdgcn_mfma_f32_32x32x16_bf16(ko, qo, sO, 0, 0, 0);
        }
    }
    float one_ = 1.0f; asm volatile("" : "+v"(one_));
#pragma unroll
    for (int r = 0; r < 16; ++r) { const int sl = (r & 3) + 8 * (r >> 2) + 4 * hf; sD[r] = (sl > r32) ? 0.f : sD[r] * one_; sO[r] *= one_; }
#pragma unroll
    for (int st = 0; st < 2; ++st) {
        o = __builtin_amdgcn_mfma_f32_32x32x16_bf16(__builtin_bit_cast(bf16x8, hD[st]), pack8(sD, 8 * st), o, 0, 0, 0);
        if (Iw) o = __builtin_amdgcn_mfma_f32_32x32x16_bf16(__builtin_bit_cast(bf16x8, hO[st]), pack8(sO, 8 * st), o, 0, 0, 0);
    }
    float ss = 0.f;
#pragma unroll
    for (int r = 0; r < 16; ++r) ss += o[r] * o[r];
    ss += __shfl_xor(ss, 32);
    if (hf == 0) part[vb * 64 + 32 * Iw + r32] = ss;
    __syncthreads();
    const int t = 32 * Iw + r32;
    const float rs = rsqrtf((part[t] + part[64 + t] + part[128 + t] + part[192 + t]) * (1.0f / 128.0f) + RMS_EPS);
    const size_t row = (size_t)(b * SEQ + c * 64 + t);
    bf16* oa = (bf16*)(a.ws() + WS_OBR) + row * 512 + h * 128 + 32 * vb + 4 * hf;
    const float* onw = a.in(I_HON) + l * 128 + 32 * vb + 4 * hf;
    f32x4 onv[4];
#pragma unroll
    for (int g = 0; g < 4; ++g) onv[g] = *(const f32x4*)(onw + 8 * g);
#pragma unroll
    for (int g = 0; g < 4; ++g) {
        const v2u gw = gwv[g];
        const float g0 = blo(gw.x), g1 = bhi(gw.x), g2 = blo(gw.y), g3 = bhi(gw.y);
        v2u wv; wv.x = cvtpk(o[4 * g] * rs * onv[g][0] * g0 * sigm(g0), o[4 * g + 1] * rs * onv[g][1] * g1 * sigm(g1));
        wv.y = cvtpk(o[4 * g + 2] * rs * onv[g][2] * g2 * sigm(g2), o[4 * g + 3] * rs * onv[g][3] * g3 * sigm(g3));
        *(v2u*)(oa + 8 * g) = wv;
    }
}

__device__ __forceinline__ void phase_mixA(const KA& a, int l, LAS unsigned char* lds) {
    for (int u = opq_bid(); u < 1024 + 512; u += gridDim.x) {
        if (u < 1024) hg_pass1_unit(a, l, u, lds);
        else { const int i = u - 1024; const int qb = (i < 256) ? 15 - (i >> 5) : ((i - 256) >> 5); for (int rep = 0; rep < REP_SB; ++rep) { sb_mfma_unit(a, (i & 31) >> 3, i & 7, qb, lds); __syncthreads(); } }
        __syncthreads();
    }
}
__device__ __forceinline__ void phase_mixC(const KA& a, int l, LAS unsigned char* lds) {
    const int bid = opq_bid();
    for (int u = bid; u < 1024; u += gridDim.x) { hg_pass3_unit(a, l, u, lds); __syncthreads(); }
    if (gridDim.x == 256) {
        const int x = bid & 7, j = bid >> 3, bh = 2 * x + (j & 1), p = j >> 1;
#pragma unroll 1
        for (int k = 0; k < 2 * REP_DF; ++k) { diff_mfma_unit(a, l, bh >> 2, bh & 3, (k & 1) ? p : 31 - p, lds); __syncthreads(); }
    }
}

#define XB_TMO      128
#define XB_XCNT(j)  (256  + 64 * (j))
#define XB_XSUB(j)  (1280 + 64 * (j))
#define XB_XGEN(j)  (2304 + 64 * (j))
#define XB_TOP      3328
#define XB_TOPGEN   3392
#define XCD_BAR_WORDS 3456
#define XB_SPIN_CAP (1u << 18)

__device__ __forceinline__ unsigned xb_ld(unsigned* p)              { return __hip_atomic_load(p, __ATOMIC_RELAXED, __HIP_MEMORY_SCOPE_AGENT); }
__device__ __forceinline__ unsigned xb_add(unsigned* p, unsigned v) { return __hip_atomic_fetch_add(p, v, __ATOMIC_RELAXED, __HIP_MEMORY_SCOPE_AGENT); }
__device__ __forceinline__ unsigned xb_xcc_id() { return (unsigned)__builtin_amdgcn_s_getreg((3 << 11) | 20) & 0xFu; }
#define XB_SPIN(cond, bar) do { unsigned _sp = 0; while (cond) { __builtin_amdgcn_s_sleep(1); \
    if ((++_sp & 255u) == 0u) { if (xb_ld(&(bar)[XB_TMO])) break; if (_sp > XB_SPIN_CAP) { (void)xb_add(&(bar)[XB_TMO], 1u); break; } } } } while (0)

struct XcdBarrier {
    unsigned* bar; unsigned x;
    volatile LAS unsigned* st;
};

__device__ __forceinline__ XcdBarrier xcd_barrier_post(unsigned* bar, volatile LAS unsigned* st) {
    XcdBarrier b; b.bar = bar; b.x = xb_xcc_id(); b.st = st;
    if (threadIdx.x == 0) (void)xb_add(&bar[XB_XCNT(b.x)], 1u);
    return b;
}
__device__ __forceinline__ void xcd_barrier_complete(unsigned* bar, unsigned x, unsigned& nloc, unsigned& nx) {
    const unsigned G = gridDim.x * gridDim.y * gridDim.z;
    unsigned sum, cnt, mine, sp = 0u;
    for (;;) {
        sum = 0u; cnt = 0u; mine = 0u;
#pragma unroll
        for (unsigned j = 0; j < 16; ++j) { const unsigned c = xb_ld(&bar[XB_XCNT(j)]); sum += c; cnt += (c > 0u) ? 1u : 0u; mine = (j == x) ? c : mine; }
        if (sum == G) break;
        __builtin_amdgcn_s_sleep(1);
        if ((++sp & 255u) == 0u) { if (xb_ld(&bar[XB_TMO])) break; if (sp > XB_SPIN_CAP) { (void)xb_add(&bar[XB_TMO], 1u); break; } }
    }
    nloc = mine > 0u ? mine : 1u; nx = cnt > 0u ? cnt : 1u;
}

__device__ __forceinline__ void xcd_barrier(const XcdBarrier& b) {
    asm volatile("s_waitcnt vmcnt(0)" ::: "memory");
    __syncthreads();
    if (threadIdx.x == 0) {
        unsigned* bar = b.bar;
        __builtin_amdgcn_s_waitcnt(0);
        unsigned nloc = b.st[0], nx = b.st[1];
        if (nloc == 0u) { xcd_barrier_complete(bar, b.x, nloc, nx); b.st[0] = nloc; b.st[1] = nx; }
        const unsigned old = xb_add(&bar[XB_XSUB(b.x)], 1u);
        const unsigned gen = old / nloc;
        if (old + 1u == (gen + 1u) * nloc) {
            __builtin_amdgcn_fence(__ATOMIC_RELEASE, "agent");
            asm volatile("s_waitcnt vmcnt(0)" ::: "memory");
            const unsigned og = xb_add(&bar[XB_TOP], 1u);
            const unsigned tg = og / nx;
            if (og + 1u == (tg + 1u) * nx) xb_add(&bar[XB_TOPGEN], 1u);
            else XB_SPIN(xb_ld(&bar[XB_TOPGEN]) == tg, bar);
            __builtin_amdgcn_fence(__ATOMIC_ACQUIRE, "agent");
            xb_add(&bar[XB_XGEN(b.x)], 1u);
            asm volatile("s_waitcnt vmcnt(0)" ::: "memory");
        } else {
            XB_SPIN(xb_ld(&bar[XB_XGEN(b.x)]) == gen, bar);
            __builtin_amdgcn_fence(__ATOMIC_ACQUIRE, "agent");
            asm volatile("s_waitcnt vmcnt(0)" ::: "memory");
        }
    }
    __syncthreads();
}


constexpr int N_PHASES = 30;
__global__ void __launch_bounds__(512, 2) mega(Args a_) {
    extern __shared__ __attribute__((aligned(16))) unsigned char lds_raw[];
    LAS unsigned char* lds = (LAS unsigned char*)lds_raw;
    volatile LAS unsigned* bst = (volatile LAS unsigned*)(lds + 131072);
    if (threadIdx.x < 4) bst[threadIdx.x] = 0u;
    __syncthreads();
    XcdBarrier gbar; gbar.bar = (unsigned*)(a_.ws + WS_BAR); gbar.x = 0; gbar.st = bst;
    if (a_.ph_hi - a_.ph_lo > 1) gbar = xcd_barrier_post((unsigned*)(a_.ws + WS_BAR), bst);
    const int ph_lo = a_.ph_lo, ph_hi = a_.ph_hi;
    for (int ph = ph_lo; ph < ph_hi; ++ph) {
        KA a;
#if defined(__HIP_DEVICE_COMPILE__)
        a.p = (KArgP)__builtin_amdgcn_kernarg_segment_ptr();
        asm volatile("" : "+s"(a.p));
#else
        a.p = nullptr;
#endif
        unsigned char* ws = a.ws();
        if (ph > ph_lo) { if (ph_lo < 0) cg::this_grid().sync(); else xcd_barrier(gbar); }
        if (ph == 0) { phase_prep(a, lds); phase_xprep(a, 0); phase_xprep(a, 1); continue; }
        if (ph == N_PHASES - 1) { phase_final(a); continue; }
        const int q = ph - 1, l = q / 14, rr = q % 14;
        const int half = (rr < 12) ? rr / 6 : 0, sub = (rr < 12) ? rr % 6 : rr - 6;
        ssq_t* ssq = (ssq_t*)(ws + WS_SSQ);
        bf16* xbh = (bf16*)(ws + WS_XB) + (size_t)half * TH * D;
        if (sub == 0) {
            const ssq_t* sq = ssq + (size_t)(2 * l) * T_ALL + (size_t)half * TH;
            pg8::Gemm g{xbh, (const bf16*)(ws + WS_WIN) + (size_t)l * 8192 * 1024, TH, 6656, 1024}; pg8::StaticOrder S; S.init(TH, 6656, gridDim.x, opq_bid());
            pg8::EpiRowScaleBf16 E{(bf16*)(ws + WS_ZMAIN), ZLD, 14, (bf16*)(ws + WS_GATES), GLD, sq};
            pg8::gemm_phase<pg8::EpiRowScaleBf16, pg8::StaticOrder, PG8_ALIGN, PG8_SP2>(lds, g, S, E);
            {
                pg8::Gemm g2{(const bf16*)(ws + WS_WIN) + (size_t)l * 8192 * 1024 + (size_t)6656 * 1024, xbh, 1536, TH, 1024}; pg8::StaticOrder S2; S2.init(1536, TH, gridDim.x, (int)gridDim.x - 1 - opq_bid());
                pg8::EpiColScaleBf16 E2{(bf16*)(ws + WS_ZT), TH, sq};
                pg8::gemm_phase<pg8::EpiColScaleBf16, pg8::StaticOrder, PG8_ALIGN, PG8_SP2>(lds, g2, S2, E2);
            }
        } else if (sub == 1) {
            phase_mixA(a, l, lds);
        } else if (sub == 2) {
            hg_pass2(a);
        } else if (sub == 3) {
            phase_mixC(a, l, lds);
        } else if (sub == 4) {
            pg8::Gemm g{(const bf16*)(ws + WS_OBR), (const bf16*)(ws + WS_WBR) + (size_t)(l * 3) * 1024 * 512, TH, 3072, 512, 4, (size_t)TH * 512};
            pg8::BranchOrder S; S.init(gridDim.x, opq_bid());
            pg8::EpiGateAcc E{(const unsigned char*)(ws + WS_GATES), (bf16*)(ws + WS_MB)};
            pg8::gemm_phase<pg8::EpiGateAcc, pg8::BranchOrder, PG8_ALIGN, PG8_SP2>(lds, g, S, E);
        } else if (sub == 5) {
            pg8::Gemm g{(const bf16*)(ws + WS_MB), (const bf16*)(ws + WS_WOUT) + (size_t)l * 1024 * 1024, TH, 1024, 1024}; pg8::StaticOrder S; S.init(TH, 1024, gridDim.x, opq_bid());
            pg8::EpiResid E{nullptr, xbh, ssq + (size_t)(2 * l + 1) * T_ALL + (size_t)half * TH};
            pg8::gemm_phase<pg8::EpiResid, pg8::StaticOrder, PG8_ALIGN, PG8_SP2>(lds, g, S, E);
        } else if (sub == 6) {
            pg8::Gemm g{(const bf16*)(ws + WS_XB), (const bf16*)(ws + WS_WUP) + (size_t)l * ULD * 1024, T_ALL, ULD, 1024}; pg8::StaticOrder S; S.init(T_ALL, ULD, gridDim.x, opq_bid());
            pg8::EpiConvGate E{(bf16*)(ws + WS_ACT), (bf16*)(ws + WS_HALO), ssq + (size_t)(2 * l + 1) * T_ALL, a.in(I_CW) + (size_t)l * 3 * ULD, a.in(I_CB) + (size_t)l * ULD};
            pg8::gemm_phase<pg8::EpiConvGate, pg8::StaticOrder, PG8_ALIGN, PG8_SP2>(lds, g, S, E);
        } else {
            pg8::Gemm g{(const bf16*)(ws + WS_ACT), (const bf16*)(ws + WS_WDN) + (size_t)l * 1024 * FF, T_ALL, 1024, FF}; pg8::StaticOrder S; S.init(T_ALL, 1024, gridDim.x, opq_bid());
            { pg8::Unit uu; for (int i = 0; S.next(i, uu); ++i) conv_fixup_tile(a, l, uu.pm); }
            asm volatile("s_waitcnt vmcnt(0)" ::: "memory"); __syncthreads();
            pg8::EpiResid E{nullptr, (bf16*)(ws + WS_XB), ssq + (size_t)(2 * l + 2) * T_ALL};
            pg8::gemm_phase<pg8::EpiResid, pg8::StaticOrder, PG8_ALIGN, PG8_SP2>(lds, g, S, E);
        }
    }
}

extern "C" void kernel_launch(void* const* d_in, const int* in_sizes, int n_in, void* d_out, int out_size, void* d_ws, size_t ws_size, hipStream_t stream) {
    static int grid = 0;
    if (grid == 0) {
        if (n_in != 18 || ws_size < WS_END) { fprintf(stderr, "kernel_launch: unexpected n_in %d / ws %zu\n", n_in, ws_size); grid = -1; return; }
        int dev = 0, cus = 0, per_cu = 0;
        hipGetDevice(&dev); hipDeviceGetAttribute(&cus, hipDeviceAttributeMultiprocessorCount, dev);
        if (hipFuncSetAttribute((const void*)mega, hipFuncAttributeMaxDynamicSharedMemorySize, LDS_BYTES) != hipSuccess) { fprintf(stderr, "hipFuncSetAttribute failed\n"); grid = -1; return; }
        if (hipOccupancyMaxActiveBlocksPerMultiprocessor(&per_cu, (const void*)mega, 512, LDS_BYTES) != hipSuccess || per_cu < 1) { fprintf(stderr, "occupancy query: %d\n", per_cu); per_cu = 1; }
        (void)hipGetLastError();
        if (cus < 256) { fprintf(stderr, "kernel_launch: this kernel is laid out for 256 CUs (got %d)\n", cus); grid = -1; return; }
        grid = 256;
    }
    if (grid < 0) return;
    if (hipMemsetAsync((char*)d_ws + WS_BAR, 0, XCD_BAR_WORDS * 4, stream) != hipSuccess) { fprintf(stderr, "memset failed\n"); return; }
    Args a{};
    for (int i = 0; i < 18; ++i) a.in[i] = (const float*)d_in[i];
    a.out = (float*)d_out; a.ws = (unsigned char*)d_ws;
#if MK_SINGLE
    a.ph_lo = 0; a.ph_hi = N_PHASES;
    void* args[] = {&a};
    hipError_t e = hipLaunchCooperativeKernel((const void*)mega, dim3(grid), dim3(512), args, LDS_BYTES, stream);
    if (e != hipSuccess) fprintf(stderr, "cooperative launch failed: %s (grid %d)\n", hipGetErrorString(e), grid);
#else
    for (int p = 0; p < N_PHASES; ++p) { a.ph_lo = p; a.ph_hi = p + 1; hipLaunchKernelGGL(mega, dim3(grid), dim3(512), LDS_BYTES, stream, a); }
#endif
}
```

```cpp
#include <hip/hip_runtime.h>
#include <hip/hip_cooperative_groups.h>
#include <cstdio>
#include <cstdint>
namespace cg = cooperative_groups;

#ifndef REP_SB
#define REP_SB 1
#endif
#ifndef REP_DF
#define REP_DF 1
#endif
#ifndef MK_SINGLE
#define MK_SINGLE 1
#endif

__device__ __forceinline__ int opq_tid() { int t = threadIdx.x; asm volatile("" : "+v"(t)); return t; }
__device__ __forceinline__ int opq_bid() { int b = blockIdx.x; asm volatile("" : "+s"(b)); return b; }

typedef unsigned long long ssq_t;
__device__ __forceinline__ float ssq_f(ssq_t v) { return __ull2float_rn(v) * 5.9604644775390625e-08f; }
__device__ __forceinline__ ssq_t ssq_q(float s) { return (ssq_t)__float2ull_rn(s * 16777216.0f); }

namespace pg8 {
#define PG8_LAS __attribute__((address_space(3)))
typedef unsigned short bf16_t;
typedef short bf16x8 __attribute__((ext_vector_type(8)));
typedef float f32x4 __attribute__((ext_vector_type(4)));
typedef unsigned u32x4 __attribute__((ext_vector_type(4)));
constexpr int BM = 256, BK = 64, HALF = 128, HTB = HALF * BK * 2  , STAGE_BYTES = 8 * HTB, NXCD = 8, WGM = 8;

__host__ __device__ __forceinline__ int lds_byte(int r, int c) { const int st = (r >> 4) * 2 + (c >> 5), rr = r & 15, cc = c & 31, ob = rr * 64 + cc * 2; return st * 1024 + (ob ^ (((ob >> 9) & 1) << 5)); }
__host__ __device__ __forceinline__ void stage_rc(int b, int& R, int& C) { const int st = b / 1024, sb = b % 1024, swz = sb ^ (((sb >> 9) & 1) << 5); R = (st >> 1) * 16 + swz / 64; C = (st & 1) * 32 + (swz % 64) / 2; }
__host__ __device__ __forceinline__ int perm32(int rho) { const int n = rho >> 4, i = rho & 15; return 8 * (i >> 2) + 4 * n + (i & 3); }

struct Unit { int pm, pn; };
struct Gemm { const bf16_t* A; const bf16_t* Bt; int M, N, K; int a_grp = 0; size_t a_stride = 0; };

struct StaticOrder {
    int nM, nN, nwg, G, c;
    __host__ __device__ void init(int M, int N, int G_, int c_) { nM = M / BM; nN = N / BM; nwg = nM * nN; G = G_; c = c_; }
    __host__ __device__ bool next(int i, Unit& u) const {
        const long L = (long)i * G + c; if (L >= nwg) return false;
        int wgid = (int)L; { const int q = nwg / NXCD, r = nwg % NXCD, xcd = wgid % NXCD, off = wgid / NXCD; wgid = (xcd < r ? xcd * (q + 1) : r * (q + 1) + (xcd - r) * q) + off; }
        const int nig = WGM * nN, gid = wgid / nig, fm = gid * WGM, gsz = (nM - fm) < WGM ? (nM - fm) : WGM;
        u.pm = fm + ((wgid % nig) % gsz); u.pn = (wgid % nig) / gsz; return true;
    }
    __device__ __forceinline__ void a_ready(const Unit&) const {}
    __device__ __forceinline__ void done(const Unit&) const {}
};
struct BranchOrder {
    int G, c;
    __host__ __device__ void init(int G_, int c_) { G = G_; c = c_; }
    __host__ __device__ bool next(int i, Unit& u) const { const int T = c + G * (i / 3), br = i % 3; if (T >= 256) return false; u.pm = T >> 2; u.pn = br * 4 + (T & 3); return true; }
    __device__ __forceinline__ void a_ready(const Unit&) const {}
    __device__ __forceinline__ void done(const Unit&) const {}
};
__device__ __forceinline__ unsigned cvt_pk_bf16(float lo, float hi) { unsigned r; asm("v_cvt_pk_bf16_f32 %0, %1, %2" : "=v"(r) : "v"(lo), "v"(hi)); return r; }
typedef unsigned u32x2 __attribute__((ext_vector_type(2)));
__device__ __forceinline__ float bflo(unsigned w) { return __uint_as_float(w << 16); }
__device__ __forceinline__ float bfhi(unsigned w) { return __uint_as_float(w & 0xffff0000u); }
__device__ __forceinline__ float sigmoidf_(float x) { return __builtin_amdgcn_rcpf(1.0f + __expf(-x)); }

struct EpiRowScaleBf16 {
    static constexpr bool PERM = true, AFTER_DRAIN = false, CHAIN = false;
    bf16_t* O0; int ld0; int split_pn; bf16_t* O1; int ld1; const ssq_t* ssq;
    __device__ __forceinline__ void operator()(const f32x4 (&acc)[2][2][4][2], const Unit& u, int wr, int wc, int fr, int fq) const {
        const int row0 = u.pm * BM + wr * 64 + fr;
        const bool sec = u.pn >= split_pn;
        bf16_t* base = sec ? O1 : O0; const int ld = sec ? ld1 : ld0;
        const int col0 = (sec ? (u.pn - split_pn) : u.pn) * BM + wc * 32 + 8 * fq;
        ssq_t sq[2][4];
#pragma unroll
        for (int ai = 0; ai < 2; ++ai)
#pragma unroll
            for (int m = 0; m < 4; ++m) sq[ai][m] = ssq[row0 + ai * HALF + m * 16];
#pragma unroll
        for (int ai = 0; ai < 2; ++ai)
#pragma unroll
            for (int m = 0; m < 4; ++m) {
                const int row = row0 + ai * HALF + m * 16;
                const float rs = rsqrtf(ssq_f(sq[ai][m]) * (1.0f / 1024.0f) + 1e-6f);
                bf16_t* rowp = base + (size_t)row * ld + col0;
#pragma unroll
                for (int bj = 0; bj < 2; ++bj) {
                    f32x4 v0 = acc[ai][bj][m][0] * rs, v1 = acc[ai][bj][m][1] * rs;
                    if (sec) {
                        unsigned q0 = 0u, q1 = 0u;
#pragma unroll
                        for (int e = 0; e < 4; ++e) {
                            q0 = __builtin_amdgcn_cvt_pk_u8_f32(__builtin_rintf(fmaxf(sigmoidf_(v0[e]) * 255.0f, 1.0f)), e, q0);
                            q1 = __builtin_amdgcn_cvt_pk_u8_f32(__builtin_rintf(fmaxf(sigmoidf_(v1[e]) * 255.0f, 1.0f)), e, q1);
                        }
                        u32x2 w8; w8.x = q0; w8.y = q1;
                        *(u32x2*)((unsigned char*)O1 + (size_t)row * ld1 + col0 + bj * HALF) = w8;
                    } else {
                    u32x4 w; w.x = cvt_pk_bf16(v0[0], v0[1]); w.y = cvt_pk_bf16(v0[2], v0[3]); w.z = cvt_pk_bf16(v1[0], v1[1]); w.w = cvt_pk_bf16(v1[2], v1[3]);
                    *(u32x4*)(rowp + bj * HALF) = w;
                    }
                }
            }
    }
};
struct EpiColScaleBf16 {
    static constexpr bool PERM = true, AFTER_DRAIN = false, CHAIN = false;
    bf16_t* O; int ld; const ssq_t* ssq;
    __device__ __forceinline__ void operator()(const f32x4 (&acc)[2][2][4][2], const Unit& u, int wr, int wc, int fr, int fq) const {
        const int row0 = u.pm * BM + wr * 64 + fr, col0 = u.pn * BM + wc * 32 + 8 * fq;
        f32x4 rs[2][2];
#pragma unroll
        for (int bj = 0; bj < 2; ++bj)
#pragma unroll
            for (int n = 0; n < 2; ++n) { ssq_t q[4];
#pragma unroll
                for (int e = 0; e < 4; ++e) q[e] = ssq[col0 + bj * HALF + 4 * n + e];
#pragma unroll
                for (int e = 0; e < 4; ++e) rs[bj][n][e] = rsqrtf(ssq_f(q[e]) * (1.0f / 1024.0f) + 1e-6f); }
#pragma unroll
        for (int ai = 0; ai < 2; ++ai)
#pragma unroll
            for (int m = 0; m < 4; ++m) {
                bf16_t* rowp = O + (size_t)(row0 + ai * HALF + m * 16) * ld + col0;
#pragma unroll
                for (int bj = 0; bj < 2; ++bj) {
                    const f32x4 v0 = acc[ai][bj][m][0] * rs[bj][0], v1 = acc[ai][bj][m][1] * rs[bj][1];
                    u32x4 w; w.x = cvt_pk_bf16(v0[0], v0[1]); w.y = cvt_pk_bf16(v0[2], v0[3]); w.z = cvt_pk_bf16(v1[0], v1[1]); w.w = cvt_pk_bf16(v1[2], v1[3]);
                    *(u32x4*)(rowp + bj * HALF) = w;
                }
            }
    }
};
__device__ __forceinline__ float dpp_ror1(float x) { return __builtin_bit_cast(float, __builtin_amdgcn_update_dpp(0, __builtin_bit_cast(int, x), 0x121, 0xf, 0xf, false)); }
__device__ __forceinline__ float dpp_ror2(float x) { return __builtin_bit_cast(float, __builtin_amdgcn_update_dpp(0, __builtin_bit_cast(int, x), 0x122, 0xf, 0xf, false)); }
struct EpiConvGate {
    static constexpr bool PERM = true, AFTER_DRAIN = false, CHAIN = false;
    bf16_t* act; bf16_t* halo; const ssq_t* ssq; const float* cw; const float* cb;
    __device__ __forceinline__ void operator()(const f32x4 (&acc)[2][2][4][2], const Unit& u, int wr, int wc, int fr_, int fq_) const {
        int lane_ = fr_ + 16 * fq_; asm volatile("" : "+v"(lane_));
#pragma unroll
        for (int n = 0; n < 2; ++n) {
#pragma unroll
            for (int ai = 0; ai < 2; ++ai) {
                asm volatile("" : "+v"(lane_));
                const int fr = lane_ & 15, fq = lane_ >> 4;
                const int row0 = u.pm * BM + wr * 64 + fr, chl = wc * 32 + 8 * fq, c0 = u.pn * 128 + chl;
                const int c = c0 + 4 * n;
                f32x4 g[4], v[4];
                ssq_t sq[4];
#pragma unroll
                for (int m = 0; m < 4; ++m) sq[m] = ssq[row0 + ai * HALF + m * 16];
#pragma unroll
                for (int m = 0; m < 4; ++m) { const float rs = rsqrtf(ssq_f(sq[m]) * (1.0f / 1024.0f) + 1e-6f); g[m] = acc[ai][0][m][n] * rs; v[m] = acc[ai][1][m][n] * rs; }
                const int grp = u.pm * 4 + ai * 2 + wr;
                bf16_t* hb = halo + (size_t)grp * 4 * 5632 + u.pn * 256 + chl + 4 * n;
                if (fr < 2) {
                    u32x2 a, b; a.x = cvt_pk_bf16(g[0][0], g[0][1]); a.y = cvt_pk_bf16(g[0][2], g[0][3]); b.x = cvt_pk_bf16(v[0][0], v[0][1]); b.y = cvt_pk_bf16(v[0][2], v[0][3]);
                    *(u32x2*)(hb + (size_t)fr * 5632) = a; *(u32x2*)(hb + (size_t)fr * 5632 + 128) = b;
                }
                if (fr >= 14) {
                    u32x2 a, b; a.x = cvt_pk_bf16(g[3][0], g[3][1]); a.y = cvt_pk_bf16(g[3][2], g[3][3]); b.x = cvt_pk_bf16(v[3][0], v[3][1]); b.y = cvt_pk_bf16(v[3][2], v[3][3]);
                    *(u32x2*)(hb + (size_t)(fr - 12) * 5632) = a; *(u32x2*)(hb + (size_t)(fr - 12) * 5632 + 128) = b;
                }
                __builtin_amdgcn_sched_barrier(0);
                {
                    const f32x4 w0 = *(const f32x4*)(cw + c), w1 = *(const f32x4*)(cw + 5632 + c), w2 = *(const f32x4*)(cw + 2 * 5632 + c), bb = *(const f32x4*)(cb + c);
                    f32x4 p1 = {0.f, 0.f, 0.f, 0.f}, p2 = p1;
#pragma unroll
                    for (int m = 0; m < 4; ++m) {
                        f32x4 r1, r2;
#pragma unroll
                        for (int e = 0; e < 4; ++e) { r1[e] = dpp_ror1(g[m][e]); r2[e] = dpp_ror2(g[m][e]); }
                        f32x4 x1, x2;
#pragma unroll
                        for (int e = 0; e < 4; ++e) { x1[e] = (fr >= 1) ? r1[e] : p1[e]; x2[e] = (fr >= 2) ? r2[e] : p2[e]; }
                        const f32x4 gg = bb + w0 * x2 + w1 * x1 + w2 * g[m];
#pragma unroll
                        for (int e = 0; e < 4; ++e) g[m][e] = gg[e] * sigmoidf_(gg[e]);
                        p1 = r1; p2 = r2;
                    }
                }
                __builtin_amdgcn_sched_barrier(0);
                {
                    const f32x4 w0 = *(const f32x4*)(cw + 2816 + c), w1 = *(const f32x4*)(cw + 5632 + 2816 + c), w2 = *(const f32x4*)(cw + 2 * 5632 + 2816 + c), bb = *(const f32x4*)(cb + 2816 + c);
                    f32x4 p1 = {0.f, 0.f, 0.f, 0.f}, p2 = p1;
#pragma unroll
                    for (int m = 0; m < 4; ++m) {
                        f32x4 r1, r2, og;
#pragma unroll
                        for (int e = 0; e < 4; ++e) { r1[e] = dpp_ror1(v[m][e]); r2[e] = dpp_ror2(v[m][e]); }
                        f32x4 x1, x2;
#pragma unroll
                        for (int e = 0; e < 4; ++e) { x1[e] = (fr >= 1) ? r1[e] : p1[e]; x2[e] = (fr >= 2) ? r2[e] : p2[e]; }
                        og = g[m] * (bb + w0 * x2 + w1 * x1 + w2 * v[m]);
                        p1 = r1; p2 = r2;
                        if (m > 0 || fr >= 2) { u32x2 w; w.x = cvt_pk_bf16(og[0], og[1]); w.y = cvt_pk_bf16(og[2], og[3]); *(u32x2*)(act + (size_t)(row0 + ai * HALF + m * 16) * 2816 + c) = w; }
                    }
                }
                __builtin_amdgcn_sched_barrier(0);
            }
        }
    }
};
struct EpiGateAcc {
    static constexpr bool PERM = true, AFTER_DRAIN = false, CHAIN = true;
    const unsigned char* gates; bf16_t* mb;
    __device__ __forceinline__ bool keep(const Unit& u) const { return (u.pn >> 2) < 2; }
    __device__ __forceinline__ void operator()(f32x4 (&acc)[2][2][4][2], const Unit& u, int wr, int wc, int fr, int fq) const {
        const int br = u.pn >> 2, gcol0 = br * 1024;
        const int row0 = u.pm * BM + wr * 64 + fr, col0 = (u.pn & 3) * BM + wc * 32 + 8 * fq;
#pragma unroll
        for (int ai = 0; ai < 2; ++ai) {
            u32x2 g[4][2], gn[4][2];
#pragma unroll
            for (int mm = 0; mm < 4; ++mm)
#pragma unroll
                for (int bj = 0; bj < 2; ++bj) {
                    const size_t off = (size_t)(row0 + ai * HALF + mm * 16) * 3072 + gcol0 + col0 + bj * HALF;
                    g[mm][bj] = *(const u32x2*)(gates + off);
                    if (br < 2) gn[mm][bj] = *(const u32x2*)(gates + off + 1024);
                }
#pragma unroll
            for (int mm = 0; mm < 4; ++mm)
#pragma unroll
                for (int bj = 0; bj < 2; ++bj) {
                    const int row = row0 + ai * HALF + mm * 16, col = col0 + bj * HALF;
                    const u32x2 gg = g[mm][bj];
                    f32x4 v0 = acc[ai][bj][mm][0], v1 = acc[ai][bj][mm][1];
#pragma unroll
                    for (int e = 0; e < 4; ++e) { v0[e] *= (float)((gg.x >> (8 * e)) & 0xffu); v1[e] *= (float)((gg.y >> (8 * e)) & 0xffu); }
                    if (br < 2) {
                        const u32x2 nn = gn[mm][bj];
#pragma unroll
                        for (int e = 0; e < 4; ++e) { v0[e] *= __builtin_amdgcn_rcpf((float)((nn.x >> (8 * e)) & 0xffu)); v1[e] *= __builtin_amdgcn_rcpf((float)((nn.y >> (8 * e)) & 0xffu)); }
                        acc[ai][bj][mm][0] = v0; acc[ai][bj][mm][1] = v1;
                    } else {
                        v0 = v0 * (1.0f / 255.0f); v1 = v1 * (1.0f / 255.0f);
                        u32x4 w; w.x = cvt_pk_bf16(v0[0], v0[1]); w.y = cvt_pk_bf16(v0[2], v0[3]); w.z = cvt_pk_bf16(v1[0], v1[1]); w.w = cvt_pk_bf16(v1[2], v1[3]);
                        *(u32x4*)(mb + (size_t)row * 1024 + col) = w;
                    }
                }
        }
    }
};
struct EpiResid {
    static constexpr bool PERM = true, AFTER_DRAIN = false, CHAIN = false;
    float* dst; bf16_t* xb; ssq_t* ssq;
    __device__ __forceinline__ void operator()(const f32x4 (&acc)[2][2][4][2], const Unit& u, int wr, int wc, int fr, int fq) const {
        const int row0 = u.pm * BM + wr * 64 + fr, col0 = u.pn * BM + wc * 32 + 8 * fq;
#pragma unroll
        for (int ai = 0; ai < 2; ++ai) {
            u32x4 px[4][2];
#pragma unroll
            for (int mm = 0; mm < 4; ++mm)
#pragma unroll
                for (int bj = 0; bj < 2; ++bj) px[mm][bj] = *(const u32x4*)(xb + (size_t)(row0 + ai * HALF + mm * 16) * 1024 + col0 + bj * HALF);
#pragma unroll
            for (int mm = 0; mm < 4; ++mm) {
                const int row = row0 + ai * HALF + mm * 16;
                float s = 0.f;
#pragma unroll
                for (int bj = 0; bj < 2; ++bj) {
                    const size_t off = (size_t)row * 1024 + col0 + bj * HALF;
                    const u32x4 p = px[mm][bj];
                    f32x4 v0 = acc[ai][bj][mm][0], v1 = acc[ai][bj][mm][1];
                    v0[0] += bflo(p.x); v0[1] += bfhi(p.x); v0[2] += bflo(p.y); v0[3] += bfhi(p.y); v1[0] += bflo(p.z); v1[1] += bfhi(p.z); v1[2] += bflo(p.w); v1[3] += bfhi(p.w);
                    if (dst) { *(f32x4*)(dst + off) = v0; *(f32x4*)(dst + off + 4) = v1; }
                    u32x4 w; w.x = cvt_pk_bf16(v0[0], v0[1]); w.y = cvt_pk_bf16(v0[2], v0[3]); w.z = cvt_pk_bf16(v1[0], v1[1]); w.w = cvt_pk_bf16(v1[2], v1[3]);
                    *(u32x4*)(xb + off) = w;
                    s += (v0[0] * v0[0] + v0[1] * v0[1]) + (v0[2] * v0[2] + v0[3] * v0[3]) + (v1[0] * v1[0] + v1[1] * v1[1]) + (v1[2] * v1[2] + v1[3] * v1[3]);
                }
                s += __shfl_xor(s, 16); s += __shfl_xor(s, 32);
                if (fq == 0) atomicAdd(ssq + row, ssq_q(s));
            }
        }
    }
};
template <class Epi, class Sched, bool ALIGN_EPI = false, bool SP2 = false>
__device__ __forceinline__ void gemm_phase(PG8_LAS unsigned char* lds, const Gemm g, const Sched& S, const Epi& E) {
    const int tid = opq_tid(), wid = __builtin_amdgcn_readfirstlane(tid >> 6), lane = tid & 63, wr = wid >> 2, wc = wid & 3, fr = lane & 15, fq = lane >> 4;
    const int K = g.K, nt = K / BK;
    unsigned voffA[2], voffB[2];
#pragma unroll
    for (int i = 0; i < 2; ++i) { int R, C; stage_rc(tid * 16 + i * 8192, R, C); const int Rb = Epi::PERM ? ((R & ~31) + perm32(R & 31)) : R;
        voffA[i] = (unsigned)(R * K + C) * 2u; voffB[i] = (unsigned)(Rb * K + C) * 2u; }
    const size_t kstep = (size_t)(BK * 2);
    const size_t hstep = (size_t)HALF * K * 2;
    const size_t tstep = 2 * hstep;
    const unsigned ldsw = (unsigned)wid * 1024u;
    const int aoff = lds_byte(wr * 64 + fr, fq * 8), boff = lds_byte(wc * 32 + fr, fq * 8);
#define PG8_SA(b, h) (((b) * 2 + (h)) * HTB)
#define PG8_SB(b, h) ((4 + (b) * 2 + (h)) * HTB)
#define PG8_STAGE(bufoff, gbase, voff) do { _Pragma("unroll") for (int _i = 0; _i < 2; ++_i) \
        __builtin_amdgcn_global_load_lds((const unsigned*)((const char*)(gbase) + (voff)[_i]), (PG8_LAS unsigned*)(lds + (bufoff) + ldsw + _i * 8192), 16, 0, 0); } while (0)
#define PG8_LDA(dst, b, h) do { _Pragma("unroll") for (int m = 0; m < 4; ++m) _Pragma("unroll") for (int k = 0; k < 2; ++k) dst[m][k] = *(const PG8_LAS bf16x8*)(lds + PG8_SA(b, h) + aoff + m * 2048 + k * 1024); } while (0)
#define PG8_LDB(dst, b, h) do { _Pragma("unroll") for (int n = 0; n < 2; ++n) _Pragma("unroll") for (int k = 0; k < 2; ++k) dst[n][k] = *(const PG8_LAS bf16x8*)(lds + PG8_SB(b, h) + boff + n * 2048 + k * 1024); } while (0)
#define PG8_MMA(ai, bj, At, Bt) do { __builtin_amdgcn_s_setprio(1); _Pragma("unroll") for (int m = 0; m < 4; ++m) _Pragma("unroll") for (int n = 0; n < 2; ++n) _Pragma("unroll") for (int k = 0; k < 2; ++k) \
        acc[ai][bj][m][n] = __builtin_amdgcn_mfma_f32_16x16x32_bf16(Bt[n][k], At[m][k], acc[ai][bj][m][n], 0, 0, 0); __builtin_amdgcn_s_setprio(0); } while (0)
#define PG8_WAIT_V(n) asm volatile("s_waitcnt vmcnt(" #n ")" ::: "memory")
#define PG8_WAIT_L(n) asm volatile("s_waitcnt lgkmcnt(" #n ")" ::: "memory")
#define PG8_BAR __builtin_amdgcn_s_barrier()
#define PG8_SCHED __builtin_amdgcn_sched_barrier(0)
    Unit cur, nxt; int ui = 0;
    if (!S.next(0, cur)) return;
    f32x4 acc[2][2][4][2];
#pragma unroll
    for (int a = 0; a < 2; ++a)
#pragma unroll
        for (int b = 0; b < 2; ++b)
#pragma unroll
            for (int m = 0; m < 4; ++m)
#pragma unroll
                for (int n = 0; n < 2; ++n) acc[a][b][m][n] = (f32x4){0.f, 0.f, 0.f, 0.f};
    bf16x8 At[4][2], B0[2][2], B1[2][2];
    const char* cA = (const char*)g.A + (size_t)cur.pm * tstep + (g.a_grp ? (size_t)(cur.pn / g.a_grp) * g.a_stride * 2 : 0); const char* cB = (const char*)g.Bt + (size_t)cur.pn * tstep;
    S.a_ready(cur);
    if constexpr (SP2) {
        PG8_STAGE(PG8_SB(0, 0), cB, voffB); PG8_STAGE(PG8_SB(0, 1), cB + hstep, voffB); PG8_STAGE(PG8_SA(0, 0), cA, voffA); PG8_STAGE(PG8_SA(0, 1), cA + hstep, voffA);
        if (wr == 1) PG8_BAR;
        PG8_WAIT_V(2); PG8_BAR;
        PG8_STAGE(PG8_SB(1, 0), cB + kstep, voffB); PG8_STAGE(PG8_SA(1, 0), cA + kstep, voffA); PG8_STAGE(PG8_SB(1, 1), cB + hstep + kstep, voffB);
        PG8_WAIT_V(6); PG8_BAR;
    } else {
        PG8_STAGE(PG8_SB(0, 0), cB, voffB); PG8_STAGE(PG8_SA(0, 0), cA, voffA); PG8_STAGE(PG8_SB(0, 1), cB + hstep, voffB); PG8_STAGE(PG8_SA(0, 1), cA + hstep, voffA);
        if (wr == 1) PG8_BAR;
        PG8_WAIT_V(4); PG8_BAR;
        PG8_STAGE(PG8_SB(1, 0), cB + kstep, voffB); PG8_STAGE(PG8_SA(1, 0), cA + kstep, voffA); PG8_STAGE(PG8_SB(1, 1), cB + hstep + kstep, voffB);
        PG8_WAIT_V(6); PG8_BAR;
    }
    for (;;) {
        const bool has_next = S.next(ui + 1, nxt);
        const char* nA = has_next ? (const char*)g.A + (size_t)nxt.pm * tstep + (g.a_grp ? (size_t)(nxt.pn / g.a_grp) * g.a_stride * 2 : 0) : cA; const char* nB = has_next ? (const char*)g.Bt + (size_t)nxt.pn * tstep : cB;
        for (int t = 0; t < nt; t += 2) {
            const bool last = (t == nt - 2);
            const char* a1 = cA + (size_t)(t + 1) * kstep;
            const char* a2 = last ? nA : cA + (size_t)(t + 2) * kstep; const char* b2 = last ? nB : cB + (size_t)(t + 2) * kstep;
            const char* a3 = a2 + kstep; const char* b3 = b2 + kstep;
            if (last && has_next) S.a_ready(nxt);
            if constexpr (SP2) {
            PG8_LDB(B0, 0, 0); PG8_LDB(B1, 0, 1); PG8_SCHED; PG8_LDA(At, 0, 0); PG8_STAGE(PG8_SA(1, 1), a1 + hstep, voffA);
            PG8_WAIT_V(8); PG8_WAIT_L(0); PG8_BAR; PG8_MMA(0, 0, At, B0); PG8_MMA(0, 1, At, B1); PG8_BAR; PG8_SCHED;
            PG8_LDA(At, 0, 1); PG8_STAGE(PG8_SB(0, 0), b2, voffB); PG8_STAGE(PG8_SB(0, 1), b2 + hstep, voffB); PG8_STAGE(PG8_SA(0, 0), a2, voffA);
            PG8_WAIT_V(8); PG8_WAIT_L(0); PG8_BAR; PG8_MMA(1, 0, At, B0); PG8_MMA(1, 1, At, B1); PG8_BAR; PG8_SCHED;
            PG8_LDB(B0, 1, 0); PG8_LDB(B1, 1, 1); PG8_SCHED; PG8_LDA(At, 1, 0); PG8_STAGE(PG8_SA(0, 1), a2 + hstep, voffA);
            PG8_WAIT_V(8); PG8_WAIT_L(0); PG8_BAR; PG8_MMA(0, 0, At, B0); PG8_MMA(0, 1, At, B1); PG8_BAR; PG8_SCHED;
            PG8_LDA(At, 1, 1); PG8_STAGE(PG8_SB(1, 0), b3, voffB); PG8_STAGE(PG8_SB(1, 1), b3 + hstep, voffB); PG8_STAGE(PG8_SA(1, 0), a3, voffA);
            PG8_WAIT_V(8); PG8_WAIT_L(0); PG8_BAR; PG8_MMA(1, 0, At, B0); PG8_MMA(1, 1, At, B1); PG8_BAR; PG8_SCHED;
            } else {
            PG8_LDB(B0, 0, 0); PG8_SCHED; PG8_LDA(At, 0, 0); PG8_STAGE(PG8_SA(1, 1), a1 + hstep, voffA);
            PG8_WAIT_L(8); PG8_BAR; PG8_WAIT_L(0); PG8_MMA(0, 0, At, B0); PG8_BAR; PG8_SCHED;
            PG8_LDB(B1, 0, 1); PG8_STAGE(PG8_SB(0, 0), b2, voffB);
            PG8_BAR; PG8_WAIT_L(0); PG8_MMA(0, 1, At, B1); PG8_BAR;
            PG8_LDA(At, 0, 1); PG8_STAGE(PG8_SA(0, 0), a2, voffA);
            PG8_BAR; PG8_WAIT_L(0); PG8_MMA(1, 0, At, B0); PG8_BAR; PG8_SCHED;
            PG8_STAGE(PG8_SB(0, 1), b2 + hstep, voffB);
            PG8_WAIT_V(6); PG8_BAR; PG8_MMA(1, 1, At, B1); PG8_BAR;
            PG8_LDB(B0, 1, 0); PG8_SCHED; PG8_LDA(At, 1, 0); PG8_STAGE(PG8_SA(0, 1), a2 + hstep, voffA);
            PG8_WAIT_L(8); PG8_BAR; PG8_WAIT_L(0); PG8_MMA(0, 0, At, B0); PG8_BAR; PG8_SCHED;
            PG8_LDB(B1, 1, 1); PG8_STAGE(PG8_SB(1, 0), b3, voffB);
            PG8_BAR; PG8_WAIT_L(0); PG8_MMA(0, 1, At, B1); PG8_BAR;
            PG8_LDA(At, 1, 1); PG8_STAGE(PG8_SA(1, 0), a3, voffA);
            PG8_BAR; PG8_WAIT_L(0); PG8_MMA(1, 0, At, B0); PG8_BAR; PG8_SCHED;
            PG8_STAGE(PG8_SB(1, 1), b3 + hstep, voffB);
            PG8_WAIT_V(6); PG8_BAR; PG8_MMA(1, 1, At, B1); PG8_BAR;
            }
        }
        if constexpr (ALIGN_EPI) { if (wr == 0) PG8_BAR; }
        if constexpr (!Epi::AFTER_DRAIN) { E(acc, cur, wr, wc, fr, fq); S.done(cur); }
        if (!has_next) break;
        bool keep_acc = false;
        if constexpr (Epi::CHAIN) keep_acc = E.keep(cur);
        if (!keep_acc) {
#pragma unroll
        for (int a = 0; a < 2; ++a)
#pragma unroll
            for (int b = 0; b < 2; ++b)
#pragma unroll
                for (int m = 0; m < 4; ++m)
#pragma unroll
                    for (int n = 0; n < 2; ++n) acc[a][b][m][n] = (f32x4){0.f, 0.f, 0.f, 0.f};
        }
        cur = nxt; cA = nA; cB = nB; ++ui;
        if constexpr (ALIGN_EPI) { if (wr == 1) PG8_BAR; }
    }
    PG8_WAIT_V(0);
    if constexpr (!ALIGN_EPI) { if (wr == 0) PG8_BAR; }
    PG8_BAR;
    if constexpr (Epi::AFTER_DRAIN) { E.fused(acc, cur, wr, wc, fr, fq, lds, wid, lane); S.done(cur); }
#undef PG8_SA
#undef PG8_SB
#undef PG8_STAGE
#undef PG8_LDA
#undef PG8_LDB
#undef PG8_MMA
#undef PG8_WAIT_V
#undef PG8_WAIT_L
#undef PG8_BAR
#undef PG8_SCHED
}
}
#ifndef PG8_SP2
#define PG8_SP2 true
#endif
#ifndef PG8_ALIGN
#define PG8_ALIGN true
#endif

#define LAS __attribute__((address_space(3)))
typedef unsigned short bf16;
typedef float f32x4 __attribute__((ext_vector_type(4)));
typedef unsigned v4u __attribute__((ext_vector_type(4)));
typedef unsigned v2u __attribute__((ext_vector_type(2)));

constexpr int T_ALL = 32768, TH = 16384, D = 1024, SEQ = 4096, NB_H = 4  ;
constexpr int ZLD = 3584, GLD = 3072, ULD = 5632, FF = 2816;
constexpr int C_HQ = 0, C_HF = 512, C_HG = 1024, C_SQ = 1536, C_SK = 2048, C_DQ = 2560, C_DK = 3072, C_HI = 3584, C_SV = 4096, C_DV = 4608;
constexpr float RMS_EPS = 1e-6f;
constexpr int LDS_BYTES = 135168;

constexpr size_t MiB = 1u << 20;
constexpr size_t WS_SSQ = 0;
constexpr size_t WS_BAR = 1536 * 1024;
constexpr size_t WS_WIN = 2 * MiB;
constexpr size_t WS_WUP = WS_WIN + 32 * MiB;
constexpr size_t WS_WDN = WS_WUP + 22 * MiB;
constexpr size_t WS_WOUT = WS_WDN + 11 * MiB;
constexpr size_t WS_WBR = WS_WOUT + 4 * MiB;
constexpr size_t WS_XB = WS_WBR + 6 * MiB;
constexpr size_t WS_OBR = WS_XB + 64 * MiB;
constexpr size_t WS_ST = WS_OBR + 48 * MiB;
constexpr size_t WS_ZT = WS_ST + 32 * MiB;
constexpr size_t WS_R1 = WS_ZT + 48 * MiB;
constexpr size_t WS_ZMAIN = WS_R1, WS_GATES = WS_R1 + 112 * MiB;
constexpr size_t WS_MB = WS_R1;
constexpr size_t WS_HALO = WS_R1, WS_ACT = WS_R1 + 24 * MiB;
constexpr size_t WS_DEC = WS_R1 + 208 * MiB;
constexpr size_t WS_END = WS_DEC + 1 * MiB;
static_assert(WS_END <= 512 * MiB, "workspace map");

struct Args { const float* in[18]; float* out; unsigned char* ws; int ph_lo, ph_hi; };
typedef const __attribute__((address_space(4))) Args* KArgP;
struct KA {
    KArgP p;
    __device__ __forceinline__ const float* in(int i) const { return p->in[i]; }
    __device__ __forceinline__ float* out() const { return p->out; }
    __device__ __forceinline__ unsigned char* ws() const { return p->ws; }
};
enum { I_X = 0, I_ANW, I_WIN, I_LB, I_HON, I_WHA, I_WSB, I_LAM, I_DON, I_WDA, I_RB, I_WOUT, I_FNW, I_WUP, I_CW, I_CB, I_WDN, I_FINW };

__device__ __forceinline__ float bf2f(bf16 b) { return __uint_as_float((unsigned)b << 16); }
__device__ __forceinline__ float blo(unsigned w) { return __uint_as_float(w << 16); }
__device__ __forceinline__ float bhi(unsigned w) { return __uint_as_float(w & 0xffff0000u); }
__device__ __forceinline__ unsigned pk2(float lo, float hi) { unsigned r; asm("v_cvt_pk_bf16_f32 %0, %1, %2" : "=v"(r) : "v"(lo), "v"(hi)); return r; }
__device__ __forceinline__ unsigned f2bf(float f) { return pk2(f, 0.f) & 0xffffu; }
__device__ __forceinline__ float wave_sum(float v) {
#pragma unroll
    for (int o = 1; o < 64; o <<= 1) v += __shfl_xor(v, o);
    return v;
}
__device__ __forceinline__ float sigm(float x) { return __builtin_amdgcn_rcpf(1.0f + __expf(-x)); }

__device__ __forceinline__ void transpose_item(const float* W, int srcN, int k0, int srcn0, const float* scale, bf16* WT, int K, int dstn0, LAS float* scr, int lane) {
    {
        const int kr = lane >> 3, c4 = (lane & 7) * 4;
        f32x4 v[8]; float scv[8];
#pragma unroll
        for (int i = 0; i < 8; ++i) { v[i] = *(const f32x4*)(W + (size_t)(k0 + 8 * i + kr) * srcN + srcn0 + c4); scv[i] = scale ? scale[k0 + 8 * i + kr] : 1.0f; }
#pragma unroll
        for (int i = 0; i < 8; ++i) {
            const int kk = 8 * i + kr; const float sc = scv[i];
            scr[kk * 33 + c4] = v[i][0] * sc; scr[kk * 33 + c4 + 1] = v[i][1] * sc; scr[kk * 33 + c4 + 2] = v[i][2] * sc; scr[kk * 33 + c4 + 3] = v[i][3] * sc;
        }
    }
    asm volatile("s_waitcnt lgkmcnt(0)" ::: "memory");
    const int c = lane & 7;
#pragma unroll
    for (int j = 0; j < 4; ++j) { const int n = (lane >> 3) + 8 * j; const LAS float* s = scr + (8 * c) * 33 + n;
        v4u o; o.x = pk2(s[0 * 33], s[1 * 33]); o.y = pk2(s[2 * 33], s[3 * 33]); o.z = pk2(s[4 * 33], s[5 * 33]); o.w = pk2(s[6 * 33], s[7 * 33]);
        *(v4u*)(WT + (size_t)(dstn0 + n) * K + k0 + 8 * c) = o; }
    asm volatile("s_waitcnt lgkmcnt(0)" ::: "memory");
}
__device__ __forceinline__ int win_src_col(int n) {
    if (n >= 3584 && n < 6656) return 5120 + (n - 3584);
    const int g = (n < 3584) ? (n >> 9) : 7 + ((n - 6656) >> 9), r = n & 511;
    const int sg = (g == 0) ? 0 : (g == 1) ? 1 : (g == 2) ? 3 : (g == 3) ? 4 : (g == 4) ? 5 : (g == 5) ? 7 : (g == 6) ? 8 : (g == 7) ? 2 : (g == 8) ? 6 : 9;
    return sg * 512 + r;
}
__device__ __forceinline__ void phase_prep(const KA& a, LAS unsigned char* lds) {
    const int tid = opq_tid(), lane = tid & 63, wave = tid >> 6;
    const int gw = opq_bid() * 8 + wave, NGW = gridDim.x * 8;
    LAS float* scr = (LAS float*)(lds + wave * 8704);
    unsigned char* ws = a.ws();
    constexpr int N_IN = 16 * 256, N_UP = 16 * 176, N_DN = 44 * 32, N_OUT = 16 * 32, N_BR = 8 * 32, PER_L = N_IN + N_UP + N_DN + N_OUT + 3 * N_BR;
    for (int it = gw; it < 2 * PER_L; it += NGW) {
        const int l = it / PER_L; int r = it % PER_L;
        if (r < N_IN) { const int kb = r / 256, nb = r % 256; transpose_item(a.in(I_WIN) + (size_t)l * 1024 * 8192, 8192, kb * 64, win_src_col(nb * 32), a.in(I_ANW) + l * 1024, (bf16*)(ws + WS_WIN) + (size_t)l * 8192 * 1024, 1024, nb * 32, scr, lane); continue; }
        r -= N_IN;
        if (r < N_UP) { const int kb = r / 176, nb = r % 176; const int n0 = nb * 32, j = n0 >> 8, rr = n0 & 255; const int sc = (rr < 128) ? (j * 128 + rr) : (FF + j * 128 + rr - 128);
            transpose_item(a.in(I_WUP) + (size_t)l * 1024 * ULD, ULD, kb * 64, sc, a.in(I_FNW) + l * 1024, (bf16*)(ws + WS_WUP) + (size_t)l * ULD * 1024, 1024, n0, scr, lane); continue; }
        r -= N_UP;
        if (r < N_DN) { const int kb = r / 32, nb = r % 32; transpose_item(a.in(I_WDN) + (size_t)l * FF * 1024, 1024, kb * 64, nb * 32, nullptr, (bf16*)(ws + WS_WDN) + (size_t)l * 1024 * FF, FF, nb * 32, scr, lane); continue; }
        r -= N_DN;
        if (r < N_OUT) { const int kb = r / 32, nb = r % 32; transpose_item(a.in(I_WOUT) + (size_t)l * 1024 * 1024, 1024, kb * 64, nb * 32, nullptr, (bf16*)(ws + WS_WOUT) + (size_t)l * 1024 * 1024, 1024, nb * 32, scr, lane); continue; }
        r -= N_OUT;
        const int br = r / N_BR; r %= N_BR; const int kb = r / 32, nb = r % 32;
        const float* src = (br == 0 ? a.in(I_WHA) : br == 1 ? a.in(I_WSB) : a.in(I_WDA)) + (size_t)l * 512 * 1024;
        transpose_item(src, 1024, kb * 64, nb * 32, nullptr, (bf16*)(ws + WS_WBR) + (size_t)(l * 3 + br) * 1024 * 512, 512, nb * 32, scr, lane);
    }
}
__device__ __forceinline__ void phase_xprep(const KA& a, int half) {
    const int tid = opq_tid(), lane = tid & 63, wave = tid >> 6;
    const int gw = opq_bid() * 8 + wave, NGW = gridDim.x * 8;
    ssq_t* ssq = (ssq_t*)(a.ws() + WS_SSQ);
    bf16* xb = (bf16*)(a.ws() + WS_XB) + (size_t)half * TH * D;
    for (int r0 = gw * 4; r0 < TH; r0 += NGW * 4) {
        f32x4 v[4][4];
#pragma unroll
        for (int q = 0; q < 4; ++q) { const f32x4* xr = (const f32x4*)(a.in(I_X) + (size_t)(half * TH + r0 + q) * D) + lane;
#pragma unroll
            for (int j = 0; j < 4; ++j) v[q][j] = xr[64 * j]; }
#pragma unroll
        for (int q = 0; q < 4; ++q) {
            const int r = r0 + q;
            v2u* o8 = (v2u*)(xb + (size_t)r * D) + lane;
            float s = 0.f;
#pragma unroll
            for (int j = 0; j < 4; ++j) { const f32x4 x = v[q][j]; s += (x[0] * x[0] + x[1] * x[1]) + (x[2] * x[2] + x[3] * x[3]); v2u w; w.x = pk2(x[0], x[1]); w.y = pk2(x[2], x[3]); o8[64 * j] = w; }
            s = wave_sum(s);
            if (lane == 0) ssq[(size_t)half * TH + r] = ssq_q(s);
            if (lane >= 1 && lane <= 4) ssq[(size_t)lane * T_ALL + (size_t)half * TH + r] = 0ull;
        }
    }
}

__device__ __forceinline__ void conv_fixup_tile(const KA& a, int l, int pm) {
    const bf16* halo = (const bf16*)(a.ws() + WS_HALO); bf16* act = (bf16*)(a.ws() + WS_ACT);
    const float* cw = a.in(I_CW) + (size_t)l * 3 * ULD; const float* cb = a.in(I_CB) + (size_t)l * ULD;
    for (int it = opq_tid(); it < 4 * (FF / 8); it += 512) {
        const int gl = it / (FF / 8), cgp = it % (FF / 8), c0 = cgp * 8, j = c0 >> 7, r = c0 & 127, gcol = j * 256 + r, vcol = gcol + 128;
        const int g = pm * 4 + gl, row = g * 64;
        float uu[4][2][8];
        const bool first = (row & (SEQ - 1)) == 0;
#pragma unroll
        for (int q = 0; q < 4; ++q) {
            const bf16* hp = (q < 2) ? halo + ((size_t)(g - 1) * 4 + 2 + q) * ULD : halo + ((size_t)g * 4 + (q - 2)) * ULD;
            v4u ag = {0u, 0u, 0u, 0u}, av = {0u, 0u, 0u, 0u};
            if (q >= 2 || !first) { ag = *(const v4u*)(hp + gcol); av = *(const v4u*)(hp + vcol); }
#pragma unroll
            for (int e = 0; e < 4; ++e) { uu[q][0][2 * e] = blo(ag[e]); uu[q][0][2 * e + 1] = bhi(ag[e]); uu[q][1][2 * e] = blo(av[e]); uu[q][1][2 * e + 1] = bhi(av[e]); }
        }
        float wg[3][8], wv[3][8], bgv[8], bvv[8];
#pragma unroll
        for (int k = 0; k < 3; ++k)
#pragma unroll
            for (int e4 = 0; e4 < 2; ++e4) { const f32x4 g4 = *(const f32x4*)(cw + k * ULD + c0 + 4 * e4), v4 = *(const f32x4*)(cw + k * ULD + FF + c0 + 4 * e4);
#pragma unroll
                for (int e = 0; e < 4; ++e) { wg[k][4 * e4 + e] = g4[e]; wv[k][4 * e4 + e] = v4[e]; } }
#pragma unroll
        for (int e4 = 0; e4 < 2; ++e4) { const f32x4 g4 = *(const f32x4*)(cb + c0 + 4 * e4), v4 = *(const f32x4*)(cb + FF + c0 + 4 * e4);
#pragma unroll
            for (int e = 0; e < 4; ++e) { bgv[4 * e4 + e] = g4[e]; bvv[4 * e4 + e] = v4[e]; } }
#pragma unroll
        for (int rr = 0; rr < 2; ++rr) {
            float o[8];
#pragma unroll
            for (int e = 0; e < 8; ++e) {
                const float gg = bgv[e] + wg[0][e] * uu[rr][0][e] + wg[1][e] * uu[rr + 1][0][e] + wg[2][e] * uu[rr + 2][0][e];
                const float vv = bvv[e] + wv[0][e] * uu[rr][1][e] + wv[1][e] * uu[rr + 1][1][e] + wv[2][e] * uu[rr + 2][1][e];
                o[e] = gg * sigm(gg) * vv;
            }
            v4u w; w.x = pk2(o[0], o[1]); w.y = pk2(o[2], o[3]); w.z = pk2(o[4], o[5]); w.w = pk2(o[6], o[7]);
            *(v4u*)(act + (size_t)(row + rr) * FF + c0) = w;
        }
    }
}

__device__ __forceinline__ void phase_final(const KA& a) {
    const int tid_ = opq_tid(); const int lane = tid_ & 63, gw = opq_bid() * 8 + (tid_ >> 6), NGW = gridDim.x * 8;
    const ssq_t* ssq = (const ssq_t*)(a.ws() + WS_SSQ);
    const f32x4* w4 = (const f32x4*)a.in(I_FINW) + lane;
    f32x4 wv[4];
#pragma unroll
    for (int j = 0; j < 4; ++j) wv[j] = w4[64 * j];
    const bf16* xb = (const bf16*)(a.ws() + WS_XB);
    for (int row0 = gw * 4; row0 < T_ALL; row0 += NGW * 4) {
        v2u v[4][4]; ssq_t sq[4];
#pragma unroll
        for (int q = 0; q < 4; ++q) { const v2u* xr = (const v2u*)(xb + (size_t)(row0 + q) * D) + lane; sq[q] = ssq[(size_t)4 * T_ALL + row0 + q];
#pragma unroll
            for (int j = 0; j < 4; ++j) v[q][j] = xr[64 * j]; }
#pragma unroll
        for (int q = 0; q < 4; ++q) {
            const float rs = rsqrtf(ssq_f(sq[q]) * (1.0f / 1024.0f) + RMS_EPS);
            f32x4* xr = (f32x4*)(a.out() + (size_t)(row0 + q) * D) + lane;
#pragma unroll
            for (int j = 0; j < 4; ++j) { const f32x4 x = {blo(v[q][j].x), bhi(v[q][j].x), blo(v[q][j].y), bhi(v[q][j].y)}; xr[64 * j] = x * rs * wv[j]; }
        }
    }
}

typedef short bf16x8 __attribute__((ext_vector_type(8)));
typedef _Float16 f16x8 __attribute__((ext_vector_type(8)));
typedef float f32x16 __attribute__((ext_vector_type(16)));
__device__ __forceinline__ unsigned cvtpk(float lo, float hi) { unsigned r; asm("v_cvt_pk_bf16_f32 %0, %1, %2" : "=v"(r) : "v"(lo), "v"(hi)); return r; }
__device__ __forceinline__ bf16x8 pack8(const f32x16& x, int o) {
    v4u w; w.x = cvtpk(x[o], x[o + 1]); w.y = cvtpk(x[o + 2], x[o + 3]); w.z = cvtpk(x[o + 4], x[o + 5]); w.w = cvtpk(x[o + 6], x[o + 7]);
    return __builtin_bit_cast(bf16x8, w);
}
__device__ __forceinline__ bf16x8 scale_bf8(v4u w, float sc) {
    v4u o;
#pragma unroll
    for (int e = 0; e < 4; ++e) o[e] = cvtpk(blo(w[e]) * sc, bhi(w[e]) * sc);
    return __builtin_bit_cast(bf16x8, o);
}
constexpr float LOG2E = 1.4426950408889634f;
__device__ __forceinline__ float max3f(float a, float b, float c) { float r; asm("v_max3_f32 %0, %1, %2, %3" : "=v"(r) : "v"(a), "v"(b), "v"(c)); return r; }
constexpr int KSTR = 144;

__device__ __forceinline__ void sb_mfma_unit(const KA& a, int b, int h, int qb, LAS unsigned char* lds) {
    const int tid = opq_tid(), lane = tid & 63, w = tid >> 6, r32 = lane & 31, hf = lane >> 5;
    const bf16* z = (const bf16*)(a.ws() + WS_ZMAIN);
    const bf16* zT = (const bf16*)(a.ws() + WS_ZT);
    bf16* ob = (bf16*)(a.ws() + WS_OBR) + (size_t)TH * 512;
    const int tq = qb * 256 + 32 * w + r32;
    const int ktmax = qb * 4 + 3, ktw = qb * 4 + (w >> 1);
    const int lrow = tid >> 3, lch = tid & 7;
    const bf16* kg = z + (size_t)(b * SEQ + lrow) * ZLD + C_SK + h * 64 + lch * 8;
    const bf16* vg = zT + (size_t)(512 + h * 64 + lrow) * TH + b * SEQ + lch * 8;
    const int lofs = lrow * KSTR + lch * 16;
    const v4u pkv = *(const v4u*)(kg + (size_t)ktmax * 64 * ZLD), pvv = *(const v4u*)(vg + ktmax * 64);
    bf16x8 qf[4];
#pragma unroll
    for (int st = 0; st < 4; ++st) qf[st] = __builtin_bit_cast(bf16x8, *(const v4u*)(z + (size_t)(b * SEQ + tq) * ZLD + C_SQ + h * 64 + 16 * st + 8 * hf));
#pragma unroll
    for (int st = 0; st < 4; ++st) qf[st] = scale_bf8(__builtin_bit_cast(v4u, qf[st]), 0.125f * LOG2E);
    f16x8 U[2], ones;
#pragma unroll
    for (int st = 0; st < 2; ++st)
#pragma unroll
        for (int j = 0; j < 8; ++j) { const int jj = 16 * st + 8 * (j >> 2) + 4 * hf + (j & 3); U[st][j] = (jj >= r32) ? (_Float16)1.0f : (_Float16)0.0f; }
#pragma unroll
    for (int j = 0; j < 8; ++j) ones[j] = (_Float16)1.0f;
    f32x16 o0, o1;
#pragma unroll
    for (int i = 0; i < 16; ++i) { o0[i] = 0.f; o1[i] = 0.f; }
    float R = 0.f; int done = 0;
    __syncthreads();
    *(LAS v4u*)(lds + lofs) = pkv; *(LAS v4u*)(lds + 9216 + lofs) = pvv;
    __syncthreads();
    for (int kt = ktmax; kt >= 0; --kt) {
        const int cur = (ktmax - kt) & 1;
        LAS unsigned char* Kb = lds + cur * 18432; LAS unsigned char* Vb = Kb + 9216;
        v4u kv, vv;
        if (kt > 0) { kv = *(const v4u*)(kg + (size_t)(kt - 1) * 64 * ZLD); vv = *(const v4u*)(vg + (kt - 1) * 64); }
        if (kt <= ktw) {
            f32x16 s0, s1;
#pragma unroll
            for (int i = 0; i < 16; ++i) { s0[i] = 0.f; s1[i] = 0.f; }
            {
                bf16x8 ka[4], kb2[4];
#pragma unroll
                for (int st = 0; st < 4; ++st) { ka[st] = *(const LAS bf16x8*)(Kb + r32 * KSTR + st * 32 + hf * 16); kb2[st] = *(const LAS bf16x8*)(Kb + (32 + r32) * KSTR + st * 32 + hf * 16); }
                __builtin_amdgcn_s_setprio(1);
#pragma unroll
                for (int st = 0; st < 4; ++st) {
                    s0 = __builtin_amdgcn_mfma_f32_32x32x16_bf16(ka[st], qf[st], s0, 0, 0, 0);
                    s1 = __builtin_amdgcn_mfma_f32_32x32x16_bf16(kb2[st], qf[st], s1, 0, 0, 0);
                }
                __builtin_amdgcn_s_setprio(0);
            }
            const bool diag = (kt == ktw);
            const int kbase = kt * 64 + 4 * hf;
            f32x16 l0, l1;
            if (!diag) {
#pragma unroll
                for (int r = 0; r < 16; ++r) {
                    { const float zz = s0[r]; const float e = __builtin_amdgcn_exp2f(-fabsf(zz)); l0[r] = -(fmaxf(zz, 0.f) + __builtin_amdgcn_logf(1.0f + e)); }
                    { const float zz = s1[r]; const float e = __builtin_amdgcn_exp2f(-fabsf(zz)); l1[r] = -(fmaxf(zz, 0.f) + __builtin_amdgcn_logf(1.0f + e)); }
                }
            } else {
#pragma unroll
                for (int r = 0; r < 16; ++r) {
                    const int krow = (r & 3) + 8 * (r >> 2);
                    { const float zz = s0[r]; const float e = __builtin_amdgcn_exp2f(-fabsf(zz)); const float l = -(fmaxf(zz, 0.f) + __builtin_amdgcn_logf(1.0f + e)); l0[r] = (kbase + krow < tq) ? l : 0.f; }
                    { const float zz = s1[r]; const float e = __builtin_amdgcn_exp2f(-fabsf(zz)); const float l = -(fmaxf(zz, 0.f) + __builtin_amdgcn_logf(1.0f + e)); l1[r] = (kbase + 32 + krow < tq) ? l : 0.f; }
                }
            }
            f16x8 lf00, lf01, lf10, lf11;
#pragma unroll
            for (int j = 0; j < 8; ++j) { lf00[j] = (_Float16)l0[j]; lf01[j] = (_Float16)l0[8 + j]; lf10[j] = (_Float16)l1[j]; lf11[j] = (_Float16)l1[8 + j]; }
            f32x16 zero;
#pragma unroll
            for (int i = 0; i < 16; ++i) zero[i] = 0.f;
            f32x16 T = __builtin_amdgcn_mfma_f32_32x32x16_f16(ones, lf10, zero, 0, 0, 0);
            T = __builtin_amdgcn_mfma_f32_32x32x16_f16(ones, lf11, T, 0, 0, 0);
            f32x16 c1 = __builtin_amdgcn_mfma_f32_32x32x16_f16(U[0], lf10, zero, 0, 0, 0);
            c1 = __builtin_amdgcn_mfma_f32_32x32x16_f16(U[1], lf11, c1, 0, 0, 0);
            f32x16 c0 = __builtin_amdgcn_mfma_f32_32x32x16_f16(U[0], lf00, T, 0, 0, 0);
            c0 = __builtin_amdgcn_mfma_f32_32x32x16_f16(U[1], lf01, c0, 0, 0, 0);
            if (!diag) {
#pragma unroll
                for (int r = 0; r < 16; ++r) { s0[r] = __builtin_amdgcn_exp2f(s0[r] + c0[r] + R); s1[r] = __builtin_amdgcn_exp2f(s1[r] + c1[r] + R); }
            } else {
#pragma unroll
                for (int r = 0; r < 16; ++r) {
                    const int krow = (r & 3) + 8 * (r >> 2);
                    const float w0 = __builtin_amdgcn_exp2f(s0[r] + c0[r] + R), w1 = __builtin_amdgcn_exp2f(s1[r] + c1[r] + R);
                    s0[r] = (kbase + krow < tq) ? w0 : 0.f; s1[r] = (kbase + 32 + krow < tq) ? w1 : 0.f;
                }
            }
            R += __shfl(c0[0], r32);
            done = __all(R < -60.0f);
            const bf16x8 p00 = pack8(s0, 0), p01 = pack8(s0, 8), p10 = pack8(s1, 0), p11 = pack8(s1, 8);
#pragma unroll
            for (int mb = 0; mb < 2; ++mb) {
                const LAS unsigned char* vr = Vb + (32 * mb + r32) * KSTR + 8 * hf;
                f32x16& oo = mb ? o1 : o0;
#pragma unroll
                for (int kb = 0; kb < 2; ++kb)
#pragma unroll
                    for (int st = 0; st < 2; ++st) {
                        const v2u lo = *(const LAS v2u*)(vr + (32 * kb + 16 * st) * 2), hi = *(const LAS v2u*)(vr + (32 * kb + 16 * st + 8) * 2);
                        v4u av; av.x = lo.x; av.y = lo.y; av.z = hi.x; av.w = hi.y;
                        const bf16x8 pf = kb ? (st ? p11 : p10) : (st ? p01 : p00);
                        oo = __builtin_amdgcn_mfma_f32_32x32x16_bf16(__builtin_bit_cast(bf16x8, av), pf, oo, 0, 0, 0);
                    }
            }
        }
        if (kt > 0) { LAS unsigned char* nb = lds + (cur ^ 1) * 18432; *(LAS v4u*)(nb + lofs) = kv; *(LAS v4u*)(nb + 9216 + lofs) = vv; }
        {
            LAS int* fl = (LAS int*)(lds + 36864) + (((ktmax - kt) & 1) << 3);
            if (lane == 0) fl[w] = done ? 1 : 0;
            __syncthreads();
            const v4u f0 = *(const LAS v4u*)fl, f1 = *(const LAS v4u*)(fl + 4);
            if ((f0.x & f0.y & f0.z & f0.w & f1.x & f1.y & f1.z & f1.w) != 0u) break;
        }
    }
    bf16* orow = ob + (size_t)(b * SEQ + tq) * 512 + h * 64 + 4 * hf;
    float one_ = 1.0f; asm volatile("" : "+v"(one_));
#pragma unroll
    for (int i = 0; i < 16; ++i) { o0[i] *= one_; o1[i] *= one_; }
#pragma unroll
    for (int g = 0; g < 4; ++g) {
        v2u w0; w0.x = cvtpk(o0[4 * g], o0[4 * g + 1]); w0.y = cvtpk(o0[4 * g + 2], o0[4 * g + 3]); *(v2u*)(orow + 8 * g) = w0;
        v2u w1; w1.x = cvtpk(o1[4 * g], o1[4 * g + 1]); w1.y = cvtpk(o1[4 * g + 2], o1[4 * g + 3]); *(v2u*)(orow + 32 + 8 * g) = w1;
    }
}
constexpr int DKSTR = 272;
__device__ __forceinline__ void diff_mfma_unit(const KA& a, int l, int b, int h, int qb, LAS unsigned char* lds) {
    const int tid = opq_tid(), lane = tid & 63, w = tid >> 6, r32 = lane & 31, hf = lane >> 5, qg = w >> 1, map = w & 1;
    const bf16* z = (const bf16*)(a.ws() + WS_ZMAIN);
    const bf16* zT = (const bf16*)(a.ws() + WS_ZT);
    bf16* oc = (bf16*)(a.ws() + WS_OBR) + (size_t)2 * TH * 512;
    constexpr int VSTR = 144;
    constexpr int STAGE = 64 * DKSTR + 128 * VSTR;
    LAS float* lut = (LAS float*)(lds + 2 * STAGE); LAS float* lamp = lut + 200;
    const int t0w = qb * 128 + 32 * qg, tq = t0w + r32;
    const int krow = tid >> 4, kch = tid & 15;
    const int vrow = tid >> 3, vch = tid & 7;
    const bf16* kg = z + (size_t)(b * SEQ + krow) * ZLD + C_DK + h * 128 + kch * 8;
    const bf16* vg = zT + (size_t)(1024 + h * 128 + vrow) * TH + b * SEQ + vch * 8;
    float rbv = 0.f, lm0 = 0.f, lm1 = 0.f, lm2 = 0.f, lm3 = 0.f;
    if (tid >= 64 && tid <= 192) {
        const int dd = tid - 64; int bucket;
        if (dd < 16) bucket = dd; else { const int lg = 16 + (int)(logf((float)dd / 16.0f) / logf(8.0f) * 16.0f); bucket = lg < 31 ? lg : 31; }
        rbv = a.in(I_RB)[bucket * 4 + h];
    }
    if (tid >= 192 && tid < 256) { const int i = tid - 192; const float* lm = a.in(I_LAM) + l * 256; lm0 = lm[i]; lm1 = lm[64 + i]; lm2 = lm[128 + i]; lm3 = lm[192 + i]; }
    bf16x8 qf[4];
#pragma unroll
    for (int st = 0; st < 4; ++st) qf[st] = __builtin_bit_cast(bf16x8, *(const v4u*)(z + (size_t)(b * SEQ + tq) * ZLD + C_DQ + h * 128 + map * 64 + 16 * st + 8 * hf));
    const v4u pk0 = *(const v4u*)(kg), pk1 = *(const v4u*)(kg + (size_t)32 * ZLD), pv0 = *(const v4u*)(vg), pv1 = *(const v4u*)(vg + (size_t)64 * TH);
    __syncthreads();
    if (tid <= 192) lut[tid] = (tid < 64) ? -INFINITY : rbv * LOG2E;
    if (tid >= 192 && tid < 256) {
        const float s1 = wave_sum(lm0 * lm1), s2 = wave_sum(lm2 * lm3);
        int lo_ = l; asm volatile("" : "+s"(lo_));
        const float lam_init = (lo_ == 0) ? 0.2f : (0.8f - 0.6f * 0.7408182206817179f);
        if (tid == 192) { lamp[0] = expf(s1) - expf(s2) + lam_init; lamp[1] = 1.0f - lam_init; }
    }
#pragma unroll
    for (int st = 0; st < 4; ++st) qf[st] = scale_bf8(__builtin_bit_cast(v4u, qf[st]), 0.125f * LOG2E);
    f32x16 o[4];
#pragma unroll
    for (int mb = 0; mb < 4; ++mb)
#pragma unroll
        for (int i = 0; i < 16; ++i) o[mb][i] = 0.f;
    float mx = -INFINITY, lsum = 0.f;
    const int ktmax = 2 * qb + 1, ktw = 2 * qb + (qg >> 1);
    const int kofs = krow * DKSTR + kch * 16, vofs = 64 * DKSTR + vrow * VSTR + (vch >> 1) * 32 + (vch & 1) * 8;
#define DF_STAGE_WRITE(nb, k0, k1, v0, v1) do { *(LAS v4u*)((nb) + kofs) = k0; *(LAS v4u*)((nb) + kofs + 32 * DKSTR) = k1; \
        *(LAS v2u*)((nb) + vofs) = (v2u){v0.x, v0.y}; *(LAS v2u*)((nb) + vofs + 16) = (v2u){v0.z, v0.w}; *(LAS v2u*)((nb) + vofs + 64 * VSTR) = (v2u){v1.x, v1.y}; *(LAS v2u*)((nb) + vofs + 64 * VSTR + 16) = (v2u){v1.z, v1.w}; } while (0)
#define DF_LDV(dst, ks) do { _Pragma("unroll") for (int mb = 0; mb < 4; ++mb) dst[mb] = *(const LAS v4u*)(vr + 32 * mb * VSTR + (ks) * 32); } while (0)
#define DF_MM(src, pf) do { _Pragma("unroll") for (int mb = 0; mb < 4; ++mb) o[mb] = __builtin_amdgcn_mfma_f32_32x32x16_bf16(__builtin_bit_cast(bf16x8, src[mb]), pf, o[mb], 0, 0, 0); } while (0)
    DF_STAGE_WRITE(lds, pk0, pk1, pv0, pv1);
    __syncthreads();
    const float bias_far = lut[192];
    float one_ = 1.0f; asm volatile("" : "+v"(one_));
    for (int kt = 0; kt <= ktmax; ++kt) {
        LAS unsigned char* Kb = lds + (kt & 1) * STAGE; LAS unsigned char* Vb = Kb + 64 * DKSTR;
        v4u k0, k1, v0, v1;
        if (kt < ktmax) { k0 = *(const v4u*)(kg + (size_t)(kt + 1) * 64 * ZLD); k1 = *(const v4u*)(kg + (size_t)((kt + 1) * 64 + 32) * ZLD); v0 = *(const v4u*)(vg + (kt + 1) * 64); v1 = *(const v4u*)(vg + (size_t)64 * TH + (kt + 1) * 64); }
        if (kt <= ktw) {
            const bool far = (t0w - (kt * 64 + 63)) >= 128;
            const float boff = far ? bias_far : 0.f;
            f32x16 s0, s1;
#pragma unroll
            for (int i = 0; i < 16; ++i) { s0[i] = 0.f; s1[i] = 0.f; }
            {
                bf16x8 ka[4], kb2[4];
#pragma unroll
                for (int st = 0; st < 4; ++st) { ka[st] = *(const LAS bf16x8*)(Kb + r32 * DKSTR + map * 128 + st * 32 + hf * 16); kb2[st] = *(const LAS bf16x8*)(Kb + (32 + r32) * DKSTR + map * 128 + st * 32 + hf * 16); }
                __builtin_amdgcn_s_setprio(1);
#pragma unroll
                for (int st = 0; st < 4; ++st) {
                    s0 = __builtin_amdgcn_mfma_f32_32x32x16_bf16(ka[st], qf[st], s0, 0, 0, 0);
                    s1 = __builtin_amdgcn_mfma_f32_32x32x16_bf16(kb2[st], qf[st], s1, 0, 0, 0);
                }
                __builtin_amdgcn_s_setprio(0);
            }
            if (!far) {
                const int kbase = kt * 64 + 4 * hf;
                float b0[16], b1[16];
#pragma unroll
                for (int r = 0; r < 16; ++r) {
                    const int kr = (r & 3) + 8 * (r >> 2);
                    const int d0 = tq - (kbase + kr);
                    b0[r] = lut[min(max(d0, -64), 128) + 64]; b1[r] = lut[min(max(d0 - 32, -64), 128) + 64];
                }
#pragma unroll
                for (int r = 0; r < 16; ++r) { s0[r] += b0[r]; s1[r] += b1[r]; }
            }
            const float s00 = s0[0] * one_, s10 = s1[0] * one_;
            float tmax = max3f(s00, s10, s0[1]);
#pragma unroll
            for (int r = 1; r < 15; ++r) tmax = max3f(tmax, s1[r], s0[r + 1]);
            tmax = fmaxf(tmax, s1[15]);
            tmax = fmaxf(tmax, __shfl_xor(tmax, 32)) + boff;
            if (__any(tmax - mx > 10.0f)) {
                const float mnew = fmaxf(mx, tmax), alpha = __builtin_amdgcn_exp2f(mx - mnew); mx = mnew; lsum *= alpha;
#pragma unroll
                for (int mb = 0; mb < 4; ++mb)
#pragma unroll
                    for (int i = 0; i < 16; ++i) o[mb][i] *= alpha;
            }
            const float cref = mx - boff;
            typedef float f32x2_ __attribute__((ext_vector_type(2)));
            f32x2_ ps2 = {0.f, 0.f};
#pragma unroll
            for (int r = 0; r < 16; r += 2) {
                f32x2_ a0 = {s0[r], s0[r + 1]}, a1 = {s1[r], s1[r + 1]};
                a0 = a0 - cref; a1 = a1 - cref;
                a0[0] = __builtin_amdgcn_exp2f(a0[0]); a0[1] = __builtin_amdgcn_exp2f(a0[1]); a1[0] = __builtin_amdgcn_exp2f(a1[0]); a1[1] = __builtin_amdgcn_exp2f(a1[1]);
                ps2 += a0; ps2 += a1;
                s0[r] = a0[0]; s0[r + 1] = a0[1]; s1[r] = a1[0]; s1[r + 1] = a1[1];
            }
            lsum += ps2[0] + ps2[1];
            const bf16x8 p00 = pack8(s0, 0), p01 = pack8(s0, 8), p10 = pack8(s1, 0), p11 = pack8(s1, 8);
            {
                const LAS unsigned char* vr = Vb + r32 * VSTR + 16 * hf; v4u avA[4], avB[4];
                __builtin_amdgcn_s_setprio(1);
                DF_LDV(avA, 0); DF_LDV(avB, 1); DF_MM(avA, p00); DF_LDV(avA, 2); DF_MM(avB, p01); DF_LDV(avB, 3); DF_MM(avA, p10); DF_MM(avB, p11);
                __builtin_amdgcn_sched_group_barrier(0x100, 8, 0); __builtin_amdgcn_sched_group_barrier(0x008, 4, 0); __builtin_amdgcn_sched_group_barrier(0x100, 4, 0);
                __builtin_amdgcn_sched_group_barrier(0x008, 4, 0); __builtin_amdgcn_sched_group_barrier(0x100, 4, 0); __builtin_amdgcn_sched_group_barrier(0x008, 8, 0);
                __builtin_amdgcn_s_setprio(0);
            }
        }
        if (kt < ktmax) { LAS unsigned char* nb = lds + ((kt + 1) & 1) * STAGE; DF_STAGE_WRITE(nb, k0, k1, v0, v1); }
        __syncthreads();
    }
#undef DF_STAGE_WRITE
#undef DF_LDV
#undef DF_MM
    lsum += __shfl_xor(lsum, 32);
    const float inv = 1.0f / lsum;
    const float lam = lamp[0], post = lamp[1];
    LAS float* ex = (LAS float*)lds + (size_t)qg * 4096 + lane;
    if (map == 1) {
#pragma unroll
        for (int mb = 0; mb < 4; ++mb)
#pragma unroll
            for (int i = 0; i < 16; ++i) ex[(mb * 16 + i) * 64] = o[mb][i] * inv;
    }
    __syncthreads();
    if (map == 0) {
        float ss = 0.f;
#pragma unroll
        for (int mb = 0; mb < 4; ++mb)
#pragma unroll
            for (int i = 0; i < 16; ++i) { const float res = o[mb][i] * inv - lam * ex[(mb * 16 + i) * 64]; o[mb][i] = res; ss += res * res; }
        ss += __shfl_xor(ss, 32);
        const float rs = rsqrtf(ss * (1.0f / 128.0f) + RMS_EPS) * post;
        const float* onw = a.in(I_DON) + l * 128;
        bf16* orow = oc + (size_t)(b * SEQ + tq) * 512 + h * 128 + 4 * hf;
        f32x4 nw[4][4];
#pragma unroll
        for (int mb = 0; mb < 4; ++mb)
#pragma unroll
            for (int g = 0; g < 4; ++g) nw[mb][g] = *(const f32x4*)(onw + 32 * mb + 8 * g + 4 * hf);
#pragma unroll
        for (int mb = 0; mb < 4; ++mb)
#pragma unroll
            for (int g = 0; g < 4; ++g) {
                v2u wv; wv.x = cvtpk(o[mb][4 * g] * rs * nw[mb][g][0], o[mb][4 * g + 1] * rs * nw[mb][g][1]); wv.y = cvtpk(o[mb][4 * g + 2] * rs * nw[mb][g][2], o[mb][4 * g + 3] * rs * nw[mb][g][3]);
                *(v2u*)(orow + 32 * mb + 8 * g) = wv;
            }
    }
}

struct HgGate { float cum[16]; float key[16]; float c15, c31, c47, last; };
__device__ __forceinline__ void hg_gates(HgGate& G, const KA& a, int l, int b, int h, int c, int tid, LAS float* segsum) {
    const int k = tid & 127, seg = tid >> 7;
    const bf16* z = (const bf16*)(a.ws() + WS_ZMAIN) + (size_t)(b * SEQ + c * 64 + seg * 16) * ZLD + C_HF + h * 128 + k;
    float lb = 0.f;
    if (l == 1) { const float a0 = a.in(I_LB)[h * 128 + k], a1 = a.in(I_LB)[512 + h * 128 + k]; lb = 1.0f / (1.0f + __expf(a0 - a1)); }
    float run = 0.f;
    bf16 zr[16];
#pragma unroll
    for (int i = 0; i < 16; ++i) zr[i] = z[(size_t)i * ZLD];
#pragma unroll
    for (int i = 0; i < 16; ++i) {
        const float zf = bf2f(zr[i]);
        const float e = __expf(-fabsf(zf));
        const float sp = __logf(1.0f + e);
        const float rc = __builtin_amdgcn_rcpf(1.0f + e); const float sg = (zf >= 0.f) ? rc : e * rc;
        float lf;
        if (l == 0) lf = -(fmaxf(-zf, 0.f) + sp);
        else lf = __logf(lb + (1.0f - lb) * sg);
        G.key[i] = (1.0f - lb) * (1.0f - sg);
        run += lf; G.cum[i] = run;
    }
    segsum[seg * 128 + k] = run;
    __syncthreads();
    const float s0 = segsum[k], s1 = segsum[128 + k], s2 = segsum[256 + k], s3 = segsum[384 + k];
    const float pre = (seg == 0) ? 0.f : (seg == 1) ? s0 : (seg == 2) ? (s0 + s1) : (s0 + s1 + s2);
#pragma unroll
    for (int i = 0; i < 16; ++i) G.cum[i] += pre;
    G.c15 = s0; G.c31 = s0 + s1; G.c47 = s0 + s1 + s2; G.last = s0 + s1 + s2 + s3;
}
__device__ __forceinline__ void hg_pass1_unit(const KA& a, int l, int ch, LAS unsigned char* lds) {
    const int tid = opq_tid(), lane = tid & 63, w = tid >> 6, r32 = lane & 31, hf = lane >> 5;
    const int c = ch & 63, h = (ch >> 6) & 3, b = ch >> 8;
    LAS float* segsum = (LAS float*)(lds + 18432);
    const int vb = w >> 1;
    const bf16* hiT = (const bf16*)(a.ws() + WS_ZT) + (size_t)(h * 128 + 32 * vb + r32) * TH + b * SEQ + c * 64 + 8 * hf;
    bf16x8 af[4];
#pragma unroll
    for (int st = 0; st < 4; ++st) af[st] = __builtin_bit_cast(bf16x8, *(const v4u*)(hiT + 16 * st));
    __syncthreads();
    HgGate G; hg_gates(G, a, l, b, h, c, tid, segsum);
    const int k = tid & 127, seg = tid >> 7;
    {
        v4u w0, w1;
#pragma unroll
        for (int e = 0; e < 4; ++e) {
            w0[e] = cvtpk(G.key[2 * e] * __expf(G.last - G.cum[2 * e]), G.key[2 * e + 1] * __expf(G.last - G.cum[2 * e + 1]));
            w1[e] = cvtpk(G.key[8 + 2 * e] * __expf(G.last - G.cum[8 + 2 * e]), G.key[9 + 2 * e] * __expf(G.last - G.cum[9 + 2 * e]));
        }
        *(LAS v4u*)(lds + k * KSTR + seg * 32) = w0; *(LAS v4u*)(lds + k * KSTR + seg * 32 + 16) = w1;
    }
    if (seg == 0) ((float*)(a.ws() + WS_DEC))[(size_t)ch * 128 + k] = __expf(G.last);
    __syncthreads();
    bf16* ST = (bf16*)(a.ws() + WS_ST) + (size_t)ch * 16384;
#pragma unroll
    for (int nn = 0; nn < 2; ++nn) {
        const int nb = 2 * (w & 1) + nn;
        f32x16 acc;
#pragma unroll
        for (int i = 0; i < 16; ++i) acc[i] = 0.f;
        bf16x8 bfr[4];
#pragma unroll
        for (int st = 0; st < 4; ++st) bfr[st] = *(const LAS bf16x8*)(lds + (32 * nb + r32) * KSTR + st * 32 + hf * 16);
        __builtin_amdgcn_s_setprio(1);
#pragma unroll
        for (int st = 0; st < 4; ++st) acc = __builtin_amdgcn_mfma_f32_32x32x16_bf16(af[st], bfr[st], acc, 0, 0, 0);
        __builtin_amdgcn_s_setprio(0);
        float one_ = 1.0f; asm volatile("" : "+v"(one_));
#pragma unroll
        for (int r = 0; r < 16; ++r) { const int v = 32 * vb + (r & 3) + 8 * (r >> 2) + 4 * hf; ST[(size_t)v * 128 + 32 * nb + r32] = (bf16)f2bf(acc[r] * one_); }
    }
}
__device__ __forceinline__ void hg_pass2(const KA& a) {
    const int gt = opq_bid() * 512 + opq_tid(), nthr = gridDim.x * 512;
    for (int it = gt; it < 16 * 8192; it += nthr) {
        const int bh = it >> 13, e2 = it & 8191;
        unsigned* ST = (unsigned*)(a.ws() + WS_ST) + (size_t)bh * 64 * 8192 + e2;
        const float* dec = (const float*)(a.ws() + WS_DEC) + (size_t)bh * 64 * 128 + 2 * (e2 & 63);
        float r0 = 0.f, r1 = 0.f;
#pragma unroll 1
        for (int cb = 0; cb < 64; cb += 32) {
            unsigned tv[32]; float d0[32], d1[32];
#pragma unroll
            for (int j = 0; j < 32; ++j) { tv[j] = ST[(size_t)(cb + j) * 8192]; d0[j] = dec[(cb + j) * 128]; d1[j] = dec[(cb + j) * 128 + 1]; }
#pragma unroll
            for (int j = 0; j < 32; ++j) {
                ST[(size_t)(cb + j) * 8192] = pk2(r0, r1);
                r0 = d0[j] * r0 + blo(tv[j]); r1 = d1[j] * r1 + bhi(tv[j]);
            }
        }
    }
}
constexpr int TSTR = 272;
__device__ __forceinline__ void hg_pass3_unit(const KA& a, int l, int ch, LAS unsigned char* lds) {
    const int tid = opq_tid(), lane = tid & 63, w = tid >> 6, r32 = lane & 31, hf = lane >> 5;
    const int c = ch & 63, h = (ch >> 6) & 3, b = ch >> 8;
    LAS unsigned char* QI = lds; LAS unsigned char* QD = lds + 64 * TSTR; LAS unsigned char* KD = lds + 128 * TSTR; LAS unsigned char* QO = lds + 192 * TSTR; LAS unsigned char* KO = lds + 224 * TSTR;
    LAS float* segsum = (LAS float*)(lds + 256 * TSTR); LAS float* part = segsum + 512;
    const int k = tid & 127, seg = tid >> 7, I = seg >> 1;
    const int vb = w >> 1, Iw = w & 1;
    bf16 qr[16];
    {
        const bf16* zq = (const bf16*)(a.ws() + WS_ZMAIN) + (size_t)(b * SEQ + c * 64 + seg * 16) * ZLD + C_HQ + h * 128 + k;
#pragma unroll
        for (int i = 0; i < 16; ++i) qr[i] = zq[(size_t)i * ZLD];
    }
    const bf16* STc = (const bf16*)(a.ws() + WS_ST) + (size_t)ch * 16384 + (size_t)(32 * vb + r32) * 128 + 8 * hf;
    v4u sa[8];
#pragma unroll
    for (int st = 0; st < 8; ++st) sa[st] = *(const v4u*)(STc + 16 * st);
    const bf16* hiT = (const bf16*)(a.ws() + WS_ZT) + (size_t)(h * 128 + 32 * vb + r32) * TH + b * SEQ + c * 64 + 4 * hf;
    v4u hD[2], hO[2];
#pragma unroll
    for (int st = 0; st < 2; ++st) {
        const v2u lo = *(const v2u*)(hiT + 32 * Iw + 16 * st), hi = *(const v2u*)(hiT + 32 * Iw + 16 * st + 8); hD[st] = (v4u){lo.x, lo.y, hi.x, hi.y};
        const v2u lo2 = *(const v2u*)(hiT + 16 * st), hi2 = *(const v2u*)(hiT + 16 * st + 8); hO[st] = (v4u){lo2.x, lo2.y, hi2.x, hi2.y};
    }
    const size_t orow_ = (size_t)(b * SEQ + c * 64 + 32 * Iw + r32);
    v2u gwv[4];
#pragma unroll
    for (int g = 0; g < 4; ++g) gwv[g] = *(const v2u*)((const bf16*)(a.ws() + WS_ZMAIN) + orow_ * ZLD + C_HG + h * 128 + 32 * vb + 4 * hf + 8 * g);
    __syncthreads();
    HgGate G; hg_gates(G, a, l, b, h, c, tid, segsum);
    {
        const float mI = I ? G.c47 : G.c15;
#pragma unroll
        for (int i = 0; i < 16; ++i) {
            const int t = seg * 16 + i;
            const float q = bf2f(qr[i]) * 0.08838834764831845f;
            *(LAS bf16*)(QI + t * TSTR + 2 * k) = (bf16)f2bf(q * __expf(G.cum[i]));
            *(LAS bf16*)(QD + t * TSTR + 2 * k) = (bf16)f2bf(q * __expf(G.cum[i] - mI));
            *(LAS bf16*)(KD + t * TSTR + 2 * k) = (bf16)f2bf(G.key[i] * __expf(mI - G.cum[i]));
            if (I) *(LAS bf16*)(QO + (t - 32) * TSTR + 2 * k) = (bf16)f2bf(q * __expf(G.cum[i] - G.c31));
            else   *(LAS bf16*)(KO + t * TSTR + 2 * k) = (bf16)f2bf(G.key[i] * __expf(G.c31 - G.cum[i]));
        }
    }
    __syncthreads();
    f32x16 sD, sO, o;
#pragma unroll
    for (int i = 0; i < 16; ++i) { sD[i] = 0.f; sO[i] = 0.f; o[i] = 0.f; }
#pragma unroll
    for (int hb = 0; hb < 8; hb += 4) {
        bf16x8 kd[4], qd[4], qi[4];
#pragma unroll
        for (int j = 0; j < 4; ++j) { const int st = hb + j;
            kd[j] = *(const LAS bf16x8*)(KD + (32 * Iw + r32) * TSTR + st * 32 + hf * 16); qd[j] = *(const LAS bf16x8*)(QD + (32 * Iw + r32) * TSTR + st * 32 + hf * 16);
            qi[j] = *(const LAS bf16x8*)(QI + (32 * Iw + r32) * TSTR + st * 32 + hf * 16); }
        __builtin_amdgcn_s_setprio(1);
#pragma unroll
        for (int j = 0; j < 4; ++j) {
            sD = __builtin_amdgcn_mfma_f32_32x32x16_bf16(kd[j], qd[j], sD, 0, 0, 0);
            o = __builtin_amdgcn_mfma_f32_32x32x16_bf16(__builtin_bit_cast(bf16x8, sa[hb + j]), qi[j], o, 0, 0, 0);
        }
        __builtin_amdgcn_s_setprio(0);
    }
    if (Iw) {
#pragma unroll
        for (int hb = 0; hb < 8; hb += 4) {
            bf16x8 ko[4], qo[4];
#pragma unroll
            for (int j = 0; j < 4; ++j) { const int st = hb + j; ko[j] = *(const LAS bf16x8*)(KO + r32 * TSTR + st * 32 + hf * 16); qo[j] = *(const LAS bf16x8*)(QO + r32 * TSTR + st * 32 + hf * 16); }
#pragma unroll
            for (int j = 0; j < 4; ++j) sO = __builtin_amdgcn_mfma_f32_32x32x16_bf16(ko[j], qo[j], sO, 0, 0, 0);
        }
    }
    float one_ = 1.0f; asm volatile("" : "+v"(one_));
#pragma unroll
    for (int r = 0; r < 16; ++r) { const int sl = (r & 3) + 8 * (r >> 2) + 4 * hf; sD[r] = (sl > r32) ? 0.f : sD[r] * one_; sO[r] *= one_; }
#pragma unroll
    for (int st = 0; st < 2; ++st) {
        o = __builtin_amdgcn_mfma_f32_32x32x16_bf16(__builtin_bit_cast(bf16x8, hD[st]), pack8(sD, 8 * st), o, 0, 0, 0);
        if (Iw) o = __builtin_amdgcn_mfma_f32_32x32x16_bf16(__builtin_bit_cast(bf16x8, hO[st]), pack8(sO, 8 * st), o, 0, 0, 0);
    }
    float ss = 0.f;
#pragma unroll
    for (int r = 0; r < 16; ++r) ss += o[r] * o[r];
    ss += __shfl_xor(ss, 32);
    if (hf == 0) part[vb * 64 + 32 * Iw + r32] = ss;
    __syncthreads();
    const int t = 32 * Iw + r32;
    const float rs = rsqrtf((part[t] + part[64 + t] + part[128 + t] + part[192 + t]) * (1.0f / 128.0f) + RMS_EPS);
    const size_t row = (size_t)(b * SEQ + c * 64 + t);
    bf16* oa = (bf16*)(a.ws() + WS_OBR) + row * 512 + h * 128 + 32 * vb + 4 * hf;
    const float* onw = a.in(I_HON) + l * 128 + 32 * vb + 4 * hf;
    f32x4 onv[4];
#pragma unroll
    for (int g = 0; g < 4; ++g) onv[g] = *(const f32x4*)(onw + 8 * g);
#pragma unroll
    for (int g = 0; g < 4; ++g) {
        const v2u gw = gwv[g];
        const float g0 = blo(gw.x), g1 = bhi(gw.x), g2 = blo(gw.y), g3 = bhi(gw.y);
        v2u wv; wv.x = cvtpk(o[4 * g] * rs * onv[g][0] * g0 * sigm(g0), o[4 * g + 1] * rs * onv[g][1] * g1 * sigm(g1));
        wv.y = cvtpk(o[4 * g + 2] * rs * onv[g][2] * g2 * sigm(g2), o[4 * g + 3] * rs * onv[g][3] * g3 * sigm(g3));
        *(v2u*)(oa + 8 * g) = wv;
    }
}

__device__ __forceinline__ void phase_mixA(const KA& a, int l, LAS unsigned char* lds) {
    for (int u = opq_bid(); u < 1024 + 512; u += gridDim.x) {
        if (u < 1024) hg_pass1_unit(a, l, u, lds);
        else { const int i = u - 1024; const int qb = (i < 256) ? 15 - (i >> 5) : ((i - 256) >> 5); for (int rep = 0; rep < REP_SB; ++rep) { sb_mfma_unit(a, (i & 31) >> 3, i & 7, qb, lds); __syncthreads(); } }
        __syncthreads();
    }
}
__device__ __forceinline__ void phase_mixC(const KA& a, int l, LAS unsigned char* lds) {
    const int bid = opq_bid();
    for (int u = bid; u < 1024; u += gridDim.x) { hg_pass3_unit(a, l, u, lds); __syncthreads(); }
    if (gridDim.x == 256) {
        const int x = bid & 7, j = bid >> 3, bh = 2 * x + (j & 1), p = j >> 1;
#pragma unroll 1
        for (int k = 0; k < 2 * REP_DF; ++k) { diff_mfma_unit(a, l, bh >> 2, bh & 3, (k & 1) ? p : 31 - p, lds); __syncthreads(); }
    }
}

#define XB_TMO      128
#define XB_XCNT(j)  (256  + 64 * (j))
#define XB_XSUB(j)  (1280 + 64 * (j))
#define XB_XGEN(j)  (2304 + 64 * (j))
#define XB_TOP      3328
#define XB_TOPGEN   3392
#define XCD_BAR_WORDS 3456
#define XB_SPIN_CAP (1u << 18)

__device__ __forceinline__ unsigned xb_ld(unsigned* p)              { return __hip_atomic_load(p, __ATOMIC_RELAXED, __HIP_MEMORY_SCOPE_AGENT); }
__device__ __forceinline__ unsigned xb_add(unsigned* p, unsigned v) { return __hip_atomic_fetch_add(p, v, __ATOMIC_RELAXED, __HIP_MEMORY_SCOPE_AGENT); }
__device__ __forceinline__ unsigned xb_xcc_id() { return (unsigned)__builtin_amdgcn_s_getreg((3 << 11) | 20) & 0xFu; }
#define XB_SPIN(cond, bar) do { unsigned _sp = 0; while (cond) { __builtin_amdgcn_s_sleep(1); \
    if ((++_sp & 255u) == 0u) { if (xb_ld(&(bar)[XB_TMO])) break; if (_sp > XB_SPIN_CAP) { (void)xb_add(&(bar)[XB_TMO], 1u); break; } } } } while (0)

struct XcdBarrier {
    unsigned* bar; unsigned x;
    volatile LAS unsigned* st;
};

__device__ __forceinline__ XcdBarrier xcd_barrier_post(unsigned* bar, volatile LAS unsigned* st) {
    XcdBarrier b; b.bar = bar; b.x = xb_xcc_id(); b.st = st;
    if (threadIdx.x == 0) (void)xb_add(&bar[XB_XCNT(b.x)], 1u);
    return b;
}
__device__ __forceinline__ void xcd_barrier_complete(unsigned* bar, unsigned x, unsigned& nloc, unsigned& nx) {
    const unsigned G = gridDim.x * gridDim.y * gridDim.z;
    unsigned sum, cnt, mine, sp = 0u;
    for (;;) {
        sum = 0u; cnt = 0u; mine = 0u;
#pragma unroll
        for (unsigned j = 0; j < 16; ++j) { const unsigned c = xb_ld(&bar[XB_XCNT(j)]); sum += c; cnt += (c > 0u) ? 1u : 0u; mine = (j == x) ? c : mine; }
        if (sum == G) break;
        __builtin_amdgcn_s_sleep(1);
        if ((++sp & 255u) == 0u) { if (xb_ld(&bar[XB_TMO])) break; if (sp > XB_SPIN_CAP) { (void)xb_add(&bar[XB_TMO], 1u); break; } }
    }
    nloc = mine > 0u ? mine : 1u; nx = cnt > 0u ? cnt : 1u;
}

__device__ __forceinline__ void xcd_barrier(const XcdBarrier& b) {
    asm volatile("s_waitcnt vmcnt(0)" ::: "memory");
    __syncthreads();
    if (threadIdx.x == 0) {
        unsigned* bar = b.bar;
        __builtin_amdgcn_s_waitcnt(0);
        unsigned nloc = b.st[0], nx = b.st[1];
        if (nloc == 0u) { xcd_barrier_complete(bar, b.x, nloc, nx); b.st[0] = nloc; b.st[1] = nx; }
        const unsigned old = xb_add(&bar[XB_XSUB(b.x)], 1u);
        const unsigned gen = old / nloc;
        if (old + 1u == (gen + 1u) * nloc) {
            __builtin_amdgcn_fence(__ATOMIC_RELEASE, "agent");
            asm volatile("s_waitcnt vmcnt(0)" ::: "memory");
            const unsigned og = xb_add(&bar[XB_TOP], 1u);
            const unsigned tg = og / nx;
            if (og + 1u == (tg + 1u) * nx) xb_add(&bar[XB_TOPGEN], 1u);
            else XB_SPIN(xb_ld(&bar[XB_TOPGEN]) == tg, bar);
            __builtin_amdgcn_fence(__ATOMIC_ACQUIRE, "agent");
            xb_add(&bar[XB_XGEN(b.x)], 1u);
            asm volatile("s_waitcnt vmcnt(0)" ::: "memory");
        } else {
            XB_SPIN(xb_ld(&bar[XB_XGEN(b.x)]) == gen, bar);
            __builtin_amdgcn_fence(__ATOMIC_ACQUIRE, "agent");
            asm volatile("s_waitcnt vmcnt(0)" ::: "memory");
        }
    }
    __syncthreads();
}


constexpr int N_PHASES = 30;
__global__ void __launch_bounds__(512, 2) mega(Args a_) {
    extern __shared__ __attribute__((aligned(16))) unsigned char lds_raw[];
    LAS unsigned char* lds = (LAS unsigned char*)lds_raw;
    volatile LAS unsigned* bst = (volatile LAS unsigned*)(lds + 131072);
    if (threadIdx.x < 4) bst[threadIdx.x] = 0u;
    __syncthreads();
    XcdBarrier gbar; gbar.bar = (unsigned*)(a_.ws + WS_BAR); gbar.x = 0; gbar.st = bst;
    if (a_.ph_hi - a_.ph_lo > 1) gbar = xcd_barrier_post((unsigned*)(a_.ws + WS_BAR), bst);
    const int ph_lo = a_.ph_lo, ph_hi = a_.ph_hi;
    for (int ph = ph_lo; ph < ph_hi; ++ph) {
        KA a;
#if defined(__HIP_DEVICE_COMPILE__)
        a.p = (KArgP)__builtin_amdgcn_kernarg_segment_ptr();
        asm volatile("" : "+s"(a.p));
#else
        a.p = nullptr;
#endif
        unsigned char* ws = a.ws();
        if (ph > ph_lo) { if (ph_lo < 0) cg::this_grid().sync(); else xcd_barrier(gbar); }
        if (ph == 0) { phase_prep(a, lds); phase_xprep(a, 0); phase_xprep(a, 1); continue; }
        if (ph == N_PHASES - 1) { phase_final(a); continue; }
        const int q = ph - 1, l = q / 14, rr = q % 14;
        const int half = (rr < 12) ? rr / 6 : 0, sub = (rr < 12) ? rr % 6 : rr - 6;
        ssq_t* ssq = (ssq_t*)(ws + WS_SSQ);
        bf16* xbh = (bf16*)(ws + WS_XB) + (size_t)half * TH * D;
        if (sub == 0) {
            const ssq_t* sq = ssq + (size_t)(2 * l) * T_ALL + (size_t)half * TH;
            pg8::Gemm g{xbh, (const bf16*)(ws + WS_WIN) + (size_t)l * 8192 * 1024, TH, 6656, 1024}; pg8::StaticOrder S; S.init(TH, 6656, gridDim.x, opq_bid());
            pg8::EpiRowScaleBf16 E{(bf16*)(ws + WS_ZMAIN), ZLD, 14, (bf16*)(ws + WS_GATES), GLD, sq};
            pg8::gemm_phase<pg8::EpiRowScaleBf16, pg8::StaticOrder, PG8_ALIGN, PG8_SP2>(lds, g, S, E);
            {
                pg8::Gemm g2{(const bf16*)(ws + WS_WIN) + (size_t)l * 8192 * 1024 + (size_t)6656 * 1024, xbh, 1536, TH, 1024}; pg8::StaticOrder S2; S2.init(1536, TH, gridDim.x, (int)gridDim.x - 1 - opq_bid());
                pg8::EpiColScaleBf16 E2{(bf16*)(ws + WS_ZT), TH, sq};
                pg8::gemm_phase<pg8::EpiColScaleBf16, pg8::StaticOrder, PG8_ALIGN, PG8_SP2>(lds, g2, S2, E2);
            }
        } else if (sub == 1) {
            phase_mixA(a, l, lds);
        } else if (sub == 2) {
            hg_pass2(a);
        } else if (sub == 3) {
            phase_mixC(a, l, lds);
        } else if (sub == 4) {
            pg8::Gemm g{(const bf16*)(ws + WS_OBR), (const bf16*)(ws + WS_WBR) + (size_t)(l * 3) * 1024 * 512, TH, 3072, 512, 4, (size_t)TH * 512};
            pg8::BranchOrder S; S.init(gridDim.x, opq_bid());
            pg8::EpiGateAcc E{(const unsigned char*)(ws + WS_GATES), (bf16*)(ws + WS_MB)};
            pg8::gemm_phase<pg8::EpiGateAcc, pg8::BranchOrder, PG8_ALIGN, PG8_SP2>(lds, g, S, E);
        } else if (sub == 5) {
            pg8::Gemm g{(const bf16*)(ws + WS_MB), (const bf16*)(ws + WS_WOUT) + (size_t)l * 1024 * 1024, TH, 1024, 1024}; pg8::StaticOrder S; S.init(TH, 1024, gridDim.x, opq_bid());
            pg8::EpiResid E{nullptr, xbh, ssq + (size_t)(2 * l + 1) * T_ALL + (size_t)half * TH};
            pg8::gemm_phase<pg8::EpiResid, pg8::StaticOrder, PG8_ALIGN, PG8_SP2>(lds, g, S, E);
        } else if (sub == 6) {
            pg8::Gemm g{(const bf16*)(ws + WS_XB), (const bf16*)(ws + WS_WUP) + (size_t)l * ULD * 1024, T_ALL, ULD, 1024}; pg8::StaticOrder S; S.init(T_ALL, ULD, gridDim.x, opq_bid());
            pg8::EpiConvGate E{(bf16*)(ws + WS_ACT), (bf16*)(ws + WS_HALO), ssq + (size_t)(2 * l + 1) * T_ALL, a.in(I_CW) + (size_t)l * 3 * ULD, a.in(I_CB) + (size_t)l * ULD};
            pg8::gemm_phase<pg8::EpiConvGate, pg8::StaticOrder, PG8_ALIGN, PG8_SP2>(lds, g, S, E);
        } else {
            pg8::Gemm g{(const bf16*)(ws + WS_ACT), (const bf16*)(ws + WS_WDN) + (size_t)l * 1024 * FF, T_ALL, 1024, FF}; pg8::StaticOrder S; S.init(T_ALL, 1024, gridDim.x, opq_bid());
            { pg8::Unit uu; for (int i = 0; S.next(i, uu); ++i) conv_fixup_tile(a, l, uu.pm); }
            asm volatile("s_waitcnt vmcnt(0)" ::: "memory"); __syncthreads();
            pg8::EpiResid E{nullptr, (bf16*)(ws + WS_XB), ssq + (size_t)(2 * l + 2) * T_ALL};
            pg8::gemm_phase<pg8::EpiResid, pg8::StaticOrder, PG8_ALIGN, PG8_SP2>(lds, g, S, E);
        }
    }
}

extern "C" void kernel_launch(void* const* d_in, const int* in_sizes, int n_in, void* d_out, int out_size, void* d_ws, size_t ws_size, hipStream_t stream) {
    static int grid = 0;
    if (grid == 0) {
        if (n_in != 18 || ws_size < WS_END) { fprintf(stderr, "kernel_launch: unexpected n_in %d / ws %zu\n", n_in, ws_size); grid = -1; return; }
        int dev = 0, cus = 0, per_cu = 0;
        hipGetDevice(&dev); hipDeviceGetAttribute(&cus, hipDeviceAttributeMultiprocessorCount, dev);
        if (hipFuncSetAttribute((const void*)mega, hipFuncAttributeMaxDynamicSharedMemorySize, LDS_BYTES) != hipSuccess) { fprintf(stderr, "hipFuncSetAttribute failed\n"); grid = -1; return; }
        if (hipOccupancyMaxActiveBlocksPerMultiprocessor(&per_cu, (const void*)mega, 512, LDS_BYTES) != hipSuccess || per_cu < 1) { fprintf(stderr, "occupancy query: %d\n", per_cu); per_cu = 1; }
        (void)hipGetLastError();
        if (cus < 256) { fprintf(stderr, "kernel_launch: this kernel is laid out for 256 CUs (got %d)\n", cus); grid = -1; return; }
        grid = 256;
    }
    if (grid < 0) return;
    if (hipMemsetAsync((char*)d_ws + WS_BAR, 0, XCD_BAR_WORDS * 4, stream) != hipSuccess) { fprintf(stderr, "memset failed\n"); return; }
    Args a{};
    for (int i = 0; i < 18; ++i) a.in[i] = (const float*)d_in[i];
    a.out = (float*)d_out; a.ws = (unsigned char*)d_ws;
#if MK_SINGLE
    a.ph_lo = 0; a.ph_hi = N_PHASES;
    void* args[] = {&a};
    hipError_t e = hipLaunchCooperativeKernel((const void*)mega, dim3(grid), dim3(512), args, LDS_BYTES, stream);
    if (e != hipSuccess) fprintf(stderr, "cooperative launch failed: %s (grid %d)\n", hipGetErrorString(e), grid);
#else
    for (int p = 0; p < N_PHASES; ++p) { a.ph_lo = p; a.ph_hi = p + 1; hipLaunchKernelGGL(mega, dim3(grid), dim3(512), LDS_BYTES, stream, a); }
#endif
}
```
